# Optimizing an MI355X kernel written in HIP

```python
import math
import jax, jax.numpy as jnp
from jax import lax
import numpy as np

D_MODEL = 1024
BATCH = 4
SEQ = 4096
DEPTH = 1

CHUNK = 128
SGU_WIDTH = D_MODEL
SGU_GROUPS = 4
SGU_GROUP_DIM = SGU_WIDTH // SGU_GROUPS
RET_HEADS = 4
RET_QK_DIM = 256
RET_V_DIM = 256
RET_WIDTH = RET_HEADS * RET_V_DIM
D_FF = 2816
ROPE_BASE = 10000.0
NORM_EPS = 1e-6
IN_WIDTHS = (SGU_WIDTH, SGU_WIDTH, RET_HEADS * RET_QK_DIM, RET_HEADS * RET_QK_DIM,
             RET_WIDTH, RET_WIDTH, D_MODEL, D_MODEL)
IN_WIDTH = sum(IN_WIDTHS)

kernel_name = "hybrid_sgu_retention_macaron_block"


def rms_norm(x, g):
    xf = x.astype(jnp.float32)
    y = xf * lax.rsqrt(jnp.mean(xf * xf, axis=-1, keepdims=True) + NORM_EPS)
    return (y * g.astype(jnp.float32)).astype(x.dtype)


def swiglu_ffn(h, w_gate, w_up, w_down):
    return (jax.nn.silu(h @ w_gate) * (h @ w_up)) @ w_down


def rotary(t):
    S, D = t.shape[1], t.shape[3]
    theta = ROPE_BASE ** (-jnp.arange(0, D, 2, dtype=jnp.float32) / D)
    ang = jnp.arange(S, dtype=jnp.float32)[:, None] * theta[None, :]
    cos = jnp.cos(ang)[None, :, None, :]
    sin = jnp.sin(ang)[None, :, None, :]
    t1, t2 = jnp.split(t.astype(jnp.float32), 2, axis=-1)
    return jnp.concatenate([t1 * cos - t2 * sin, t2 * cos + t1 * sin], axis=-1)


def spatial_gating(u, v, norm_g, norm_b, w_s, b_s):
    B, S, _ = v.shape
    vf = v.astype(jnp.float32)
    mu = jnp.mean(vf, axis=-1, keepdims=True)
    var = jnp.mean(jnp.square(vf - mu), axis=-1, keepdims=True)
    vn = (vf - mu) * lax.rsqrt(var + NORM_EPS) * norm_g + norm_b
    vc = vn.reshape(B, S // CHUNK, CHUNK, SGU_GROUPS, SGU_GROUP_DIM)
    s = jnp.einsum('gcm,bnmgd->bncgd', w_s.astype(jnp.float32), vc)
    s = s + b_s.astype(jnp.float32).T[None, None, :, :, None]
    return u * s.reshape(B, S, SGU_WIDTH).astype(u.dtype)


def retention_direction(q, k, v, log_gamma, include_diag):
    C = q.shape[3]
    idx = jnp.arange(C, dtype=jnp.float32)
    diff = idx[:, None] - idx[None, :]
    keep = (diff >= 0) if include_diag else (diff > 0)
    lg = log_gamma[:, None, None]
    decay = jnp.where(keep[None], jnp.exp(jnp.maximum(diff, 0.0)[None] * lg), 0.0)
    scores = jnp.einsum('bhncd,bhnmd->bhncm', q, k) * decay[None, :, None]
    intra = jnp.einsum('bhncm,bhnme->bhnce', scores, v)
    q_dec = q * jnp.exp((idx + 1.0)[None, :] * log_gamma[:, None])[None, :, None, :, None]
    k_dec = k * jnp.exp((C - 1.0 - idx)[None, :] * log_gamma[:, None])[None, :, None, :, None]
    chunk_decay = jnp.exp(C * log_gamma)[None, :, None, None]

    def step(state, xs):
        qn, kn, vn = xs
        out = jnp.einsum('bhcd,bhde->bhce', qn, state)
        state = state * chunk_decay + jnp.einsum('bhcd,bhce->bhde', kn, vn)
        return state, out

    B, H = q.shape[0], q.shape[1]
    init = jnp.zeros((B, H, q.shape[-1], v.shape[-1]), jnp.float32)
    xs = (jnp.moveaxis(q_dec, 2, 0), jnp.moveaxis(k_dec, 2, 0), jnp.moveaxis(v, 2, 0))
    _, cross = lax.scan(step, init, xs)
    return intra + jnp.moveaxis(cross, 0, 2)


def bidirectional_retention(q, k, v, decay_logit):
    B, S, H, dv = v.shape
    N = S // CHUNK
    log_gamma = jax.nn.log_sigmoid(decay_logit.astype(jnp.float32))

    def chunk(t):
        return jnp.transpose(t.astype(jnp.float32), (0, 2, 1, 3)).reshape(B, H, N, CHUNK, t.shape[-1])

    def rev(t):
        return jnp.flip(t, axis=1)

    fwd = retention_direction(chunk(q), chunk(k), chunk(v), log_gamma[0], True)
    bwd = retention_direction(chunk(rev(q)), chunk(rev(k)), chunk(rev(v)), log_gamma[1], False)
    out = fwd.reshape(B, H, S, dv) + jnp.flip(bwd.reshape(B, H, S, dv), axis=2)
    return jnp.transpose(out, (0, 2, 1, 3))


def setup_inputs(seed: int = 0) -> dict:
    key = jax.random.key(seed)
    ks = jax.random.split(key, 24)
    L, D = DEPTH, D_MODEL

    def nrm(k, shape, scale):
        return jax.random.normal(k, shape, jnp.float32) * scale

    base_logit = jnp.log(2.0 ** (5.0 + jnp.arange(RET_HEADS, dtype=jnp.float32)) - 1.0)
    return {
        "x": nrm(ks[0], (BATCH, SEQ, D), 1.0),
        "ffn1_norm": 1.0 + nrm(ks[1], (L, D), 0.02),
        "ffn1_w_gate": nrm(ks[2], (L, D, D_FF), D ** -0.5),
        "ffn1_w_up": nrm(ks[3], (L, D, D_FF), D ** -0.5),
        "ffn1_w_down": nrm(ks[4], (L, D_FF, D), D_FF ** -0.5),
        "mix_norm": 1.0 + nrm(ks[5], (L, D), 0.02),
        "w_in": nrm(ks[6], (L, D, IN_WIDTH), D ** -0.5),
        "b_in": nrm(ks[7], (L, IN_WIDTH), 0.02),
        "sgu_norm_g": 1.0 + nrm(ks[8], (L, SGU_WIDTH), 0.02),
        "sgu_norm_b": nrm(ks[9], (L, SGU_WIDTH), 0.02),
        "sgu_w_s": nrm(ks[10], (L, SGU_GROUPS, CHUNK, CHUNK), CHUNK ** -0.5),
        "sgu_b_s": 1.0 + nrm(ks[11], (L, SGU_GROUPS, CHUNK), 0.1),
        "ret_decay_logit": jnp.broadcast_to(base_logit, (L, 2, RET_HEADS)) + nrm(ks[12], (L, 2, RET_HEADS), 0.05),
        "w_branch_a": nrm(ks[13], (L, SGU_WIDTH, D), SGU_WIDTH ** -0.5),
        "w_branch_b": nrm(ks[14], (L, RET_WIDTH, D), RET_WIDTH ** -0.5),
        "w_out": nrm(ks[15], (L, D, D), D ** -0.5),
        "ffn2_norm": 1.0 + nrm(ks[16], (L, D), 0.02),
        "ffn2_w_gate": nrm(ks[17], (L, D, D_FF), D ** -0.5),
        "ffn2_w_up": nrm(ks[18], (L, D, D_FF), D ** -0.5),
        "ffn2_w_down": nrm(ks[19], (L, D_FF, D), D_FF ** -0.5),
        "final_norm": 1.0 + nrm(ks[20], (D,), 0.02),
    }


def reference(x, ffn1_norm, ffn1_w_gate, ffn1_w_up, ffn1_w_down, mix_norm, w_in, b_in,
              sgu_norm_g, sgu_norm_b, sgu_w_s, sgu_b_s, ret_decay_logit,
              w_branch_a, w_branch_b, w_out, ffn2_norm, ffn2_w_gate, ffn2_w_up, ffn2_w_down,
              final_norm):
    B, S, _ = x.shape
    split_at = list(np.cumsum(IN_WIDTHS)[:-1])
    for l in range(DEPTH):
        x = x + 0.5 * swiglu_ffn(rms_norm(x, ffn1_norm[l]), ffn1_w_gate[l], ffn1_w_up[l], ffn1_w_down[l])

        h = rms_norm(x, mix_norm[l])
        proj = h @ w_in[l] + b_in[l]
        u_a, v_a, q_r, k_r, v_r, g_r, gate_a, gate_b = jnp.split(proj, split_at, axis=-1)

        a = spatial_gating(jax.nn.gelu(u_a, approximate=False), jax.nn.gelu(v_a, approximate=False),
                           sgu_norm_g[l], sgu_norm_b[l], sgu_w_s[l], sgu_b_s[l])

        q = rotary(q_r.reshape(B, S, RET_HEADS, RET_QK_DIM))
        k = rotary(k_r.reshape(B, S, RET_HEADS, RET_QK_DIM)) * (RET_QK_DIM ** -0.5)
        v = v_r.reshape(B, S, RET_HEADS, RET_V_DIM)
        r = bidirectional_retention(q, k, v, ret_decay_logit[l])
        r = r * lax.rsqrt(jnp.mean(r * r, axis=-1, keepdims=True) + NORM_EPS)
        r = r.reshape(B, S, RET_WIDTH).astype(x.dtype) * jax.nn.silu(g_r)

        mix = jax.nn.sigmoid(gate_a) * (a @ w_branch_a[l]) + jax.nn.sigmoid(gate_b) * (r @ w_branch_b[l])
        x = x + mix @ w_out[l]

        x = x + 0.5 * swiglu_ffn(rms_norm(x, ffn2_norm[l]), ffn2_w_gate[l], ffn2_w_up[l], ffn2_w_down[l])
    return rms_norm(x, final_norm)
```

```cpp
#include <hip/hip_runtime.h>
#include <hip/hip_cooperative_groups.h>
#include <cstdio>
#include <cstdint>
namespace cg = cooperative_groups;
namespace pg8 {
#define PG8_LAS __attribute__((address_space(3)))
typedef unsigned short bf16_t;
typedef short bf16x8 __attribute__((ext_vector_type(8)));
typedef float f32x4 __attribute__((ext_vector_type(4)));
typedef unsigned u32x4 __attribute__((ext_vector_type(4)));
constexpr int BM = 256, BK = 64, HALF = 128, HTB = HALF * BK * 2  , STAGE_BYTES = 8 * HTB, NXCD = 8, WGM = 4;

__host__ __device__ __forceinline__ int lds_byte(int r, int c) { const int st = (r >> 4) * 2 + (c >> 5), rr = r & 15, cc = c & 31, ob = rr * 64 + cc * 2; return st * 1024 + (ob ^ (((ob >> 9) & 1) << 5)); }
__host__ __device__ __forceinline__ void stage_rc(int b, int& R, int& C) { const int st = b / 1024, sb = b % 1024, swz = sb ^ (((sb >> 9) & 1) << 5); R = (st >> 1) * 16 + swz / 64; C = (st & 1) * 32 + (swz % 64) / 2; }
__host__ __device__ __forceinline__ int perm32(int rho) { const int n = rho >> 4, i = rho & 15; return 8 * (i >> 2) + 4 * n + (i & 3); }

struct Unit { int pm, pn; };
struct Gemm { const bf16_t* A; const bf16_t* Bt; int M, N, K; };

struct StaticOrder {
    int nM, nN, nwg, G, c;
    __host__ __device__ void init(int M, int N, int G_, int c_) { nM = M / BM; nN = N / BM; nwg = nM * nN; G = G_; c = c_; }
    __host__ __device__ bool next(int i, Unit& u) const {
        const long L = (long)i * G + c; if (L >= nwg) return false;
        int wgid = (int)L; { const int q = nwg / NXCD, r = nwg % NXCD, xcd = wgid % NXCD, off = wgid / NXCD; wgid = (xcd < r ? xcd * (q + 1) : r * (q + 1) + (xcd - r) * q) + off; }
        const int nig = WGM * nN, gid = wgid / nig, fm = gid * WGM, gsz = (nM - fm) < WGM ? (nM - fm) : WGM;
        u.pm = fm + ((wgid % nig) % gsz); u.pn = (wgid % nig) / gsz; return true;
    }
    __device__ __forceinline__ void a_ready(const Unit&) const {}
    __device__ __forceinline__ void done(const Unit&) const {}
};
__device__ __forceinline__ unsigned cvt_pk_bf16(float lo, float hi) { unsigned r; asm volatile("v_cvt_pk_bf16_f32 %0, %1, %2" : "=v"(r) : "v"(lo), "v"(hi)); return r; }
typedef float f32x2 __attribute__((ext_vector_type(2)));
__device__ __forceinline__ f32x2 gelu_pk(f32x2 v) {
    const f32x2 av = __builtin_elementwise_abs(v), d = av * 0.2316418882f + 1.0f;
    f32x2 t; t.x = __builtin_amdgcn_rcpf(d.x); t.y = __builtin_amdgcn_rcpf(d.y);
    f32x2 q = t * 0.5307027145f + (-0.7265760135f); q = q * t + 0.7107068705f; q = q * t + (-0.142248368f); q = q * t + 0.127414796f; q = q * t;
    const f32x2 s = (v * v) * (-0.72134752044f);
    f32x2 e; e.x = __builtin_amdgcn_exp2f(s.x); e.y = __builtin_amdgcn_exp2f(s.y);
    const f32x2 m = v * (q * e), r = v - m;
    f32x2 o; o.x = v.x < 0.f ? m.x : r.x; o.y = v.y < 0.f ? m.y : r.y; return o;
}
template <class Epi, class Sched, bool ALIGN_EPI = false, bool SP2 = false, bool ABLK = false>
__device__ __forceinline__ void gemm_phase(PG8_LAS unsigned char* lds, const Gemm g, const Sched& S, const Epi& E) {
    int tid_ = threadIdx.x; asm volatile("" : "+v"(tid_));
    const int tid = tid_, wid = __builtin_amdgcn_readfirstlane(tid >> 6), lane = tid & 63, wr = wid >> 2, wc = wid & 3, fr = lane & 15, fq = lane >> 4;
    const int K = g.K, nt = K / BK;
    unsigned voffA[2], voffB[2];
#pragma unroll
    for (int i = 0; i < 2; ++i) { int R, C; stage_rc(tid * 16 + i * 8192, R, C); const int Rb = Epi::PERM ? ((R & ~31) + perm32(R & 31)) : R;
        voffA[i] = ABLK ? (unsigned)(R * BK + C) * 2u : (unsigned)(R * K + C) * 2u; voffB[i] = (unsigned)(Rb * K + C) * 2u; }
    const size_t kstep = (size_t)(BK * 2);
    const size_t hstep = (size_t)HALF * K * 2;
    const size_t tstep = 2 * hstep;
    const size_t kstepA = ABLK ? (size_t)(BM * BK * 2) : kstep, hstepA = ABLK ? (size_t)(HALF * BK * 2) : hstep, tstepA = ABLK ? (size_t)(K / BK) * (size_t)(BM * BK * 2) : tstep;
    const unsigned ldsw = (unsigned)wid * 1024u;
    const int aoff = lds_byte(wr * 64 + fr, fq * 8), boff = lds_byte(wc * 32 + fr, fq * 8);
#define PG8_SA(b, h) (((b) * 2 + (h)) * HTB)
#define PG8_SB(b, h) ((4 + (b) * 2 + (h)) * HTB)
#define PG8_STAGE(bufoff, gbase, voff) do { _Pragma("unroll") for (int _i = 0; _i < 2; ++_i) \
        __builtin_amdgcn_global_load_lds((const unsigned*)((const char*)(gbase) + (voff)[_i]), (PG8_LAS unsigned*)(lds + (bufoff) + ldsw + _i * 8192), 16, 0, 0); } while (0)
#define PG8_LDA(dst, b, h) do { _Pragma("unroll") for (int m = 0; m < 4; ++m) _Pragma("unroll") for (int k = 0; k < 2; ++k) dst[m][k] = *(const PG8_LAS bf16x8*)(lds + PG8_SA(b, h) + aoff + m * 2048 + k * 1024); } while (0)
#define PG8_LDB(dst, b, h) do { _Pragma("unroll") for (int n = 0; n < 2; ++n) _Pragma("unroll") for (int k = 0; k < 2; ++k) dst[n][k] = *(const PG8_LAS bf16x8*)(lds + PG8_SB(b, h) + boff + n * 2048 + k * 1024); } while (0)
#define PG8_MMA(ai, bj, At, Bt) do { __builtin_amdgcn_s_setprio(1); _Pragma("unroll") for (int m = 0; m < 4; ++m) _Pragma("unroll") for (int n = 0; n < 2; ++n) _Pragma("unroll") for (int k = 0; k < 2; ++k) \
        acc[ai][bj][m][n] = __builtin_amdgcn_mfma_f32_16x16x32_bf16(Bt[n][k], At[m][k], acc[ai][bj][m][n], 0, 0, 0); __builtin_amdgcn_s_setprio(0); } while (0)
#define PG8_WAIT_V(n) asm volatile("s_waitcnt vmcnt(" #n ")" ::: "memory")
#define PG8_WAIT_L(n) asm volatile("s_waitcnt lgkmcnt(" #n ")" ::: "memory")
#define PG8_BAR __builtin_amdgcn_s_barrier()
#define PG8_SCHED __builtin_amdgcn_sched_barrier(0)
    Unit cur, nxt; int ui = 0;
    if (!S.next(0, cur)) return;
    f32x4 acc[2][2][4][2];
    if constexpr (Epi::ACC_INIT) E.init(acc, cur, wr, wc, fr, fq);
    else {
#pragma unroll
    for (int a = 0; a < 2; ++a)
#pragma unroll
        for (int b = 0; b < 2; ++b)
#pragma unroll
            for (int m = 0; m < 4; ++m)
#pragma unroll
                for (int n = 0; n < 2; ++n) acc[a][b][m][n] = (f32x4){0.f, 0.f, 0.f, 0.f};
    }
    bf16x8 At[4][2], B0[2][2], B1[2][2];
    const char* cA = (const char*)g.A + (size_t)cur.pm * tstepA; const char* cB = (const char*)g.Bt + (size_t)cur.pn * tstep;
    S.a_ready(cur);
    if constexpr (SP2) {
        PG8_STAGE(PG8_SB(0, 0), cB, voffB); PG8_STAGE(PG8_SB(0, 1), cB + hstep, voffB); PG8_STAGE(PG8_SA(0, 0), cA, voffA); PG8_STAGE(PG8_SA(0, 1), cA + hstepA, voffA);
        if (wr == 1) PG8_BAR;
        PG8_WAIT_V(2); PG8_BAR;
        PG8_STAGE(PG8_SB(1, 0), cB + kstep, voffB); PG8_STAGE(PG8_SA(1, 0), cA + kstepA, voffA); PG8_STAGE(PG8_SB(1, 1), cB + hstep + kstep, voffB);
        PG8_WAIT_V(6); PG8_BAR;
    } else {
        PG8_STAGE(PG8_SB(0, 0), cB, voffB); PG8_STAGE(PG8_SA(0, 0), cA, voffA); PG8_STAGE(PG8_SB(0, 1), cB + hstep, voffB); PG8_STAGE(PG8_SA(0, 1), cA + hstepA, voffA);
        if (wr == 1) PG8_BAR;
        PG8_WAIT_V(4); PG8_BAR;
        PG8_STAGE(PG8_SB(1, 0), cB + kstep, voffB); PG8_STAGE(PG8_SA(1, 0), cA + kstepA, voffA); PG8_STAGE(PG8_SB(1, 1), cB + hstep + kstep, voffB);
        PG8_WAIT_V(6); PG8_BAR;
    }
    for (;;) {
        const bool has_next = S.next(ui + 1, nxt);
        const char* nA = has_next ? (const char*)g.A + (size_t)nxt.pm * tstepA : cA; const char* nB = has_next ? (const char*)g.Bt + (size_t)nxt.pn * tstep : cB;
        for (int t = 0; t < nt; t += 2) {
            const bool last = (t == nt - 2);
            const char* a1 = cA + (size_t)(t + 1) * kstepA;
            const char* a2 = last ? nA : cA + (size_t)(t + 2) * kstepA; const char* b2 = last ? nB : cB + (size_t)(t + 2) * kstep;
            const char* a3 = a2 + kstepA; const char* b3 = b2 + kstep;
            if (last && has_next) S.a_ready(nxt);
            if constexpr (SP2) {
            PG8_LDB(B0, 0, 0); PG8_LDB(B1, 0, 1); PG8_SCHED; PG8_LDA(At, 0, 0); PG8_STAGE(PG8_SA(1, 1), a1 + hstepA, voffA);
            PG8_WAIT_V(8); PG8_WAIT_L(0); PG8_BAR; PG8_MMA(0, 0, At, B0); PG8_MMA(0, 1, At, B1); PG8_BAR; PG8_SCHED;
            PG8_LDA(At, 0, 1); PG8_STAGE(PG8_SB(0, 0), b2, voffB); PG8_STAGE(PG8_SB(0, 1), b2 + hstep, voffB); PG8_STAGE(PG8_SA(0, 0), a2, voffA);
            PG8_WAIT_V(8); PG8_WAIT_L(0); PG8_BAR; PG8_MMA(1, 0, At, B0); PG8_MMA(1, 1, At, B1); PG8_BAR; PG8_SCHED;
            PG8_LDB(B0, 1, 0); PG8_LDB(B1, 1, 1); PG8_SCHED; PG8_LDA(At, 1, 0); PG8_STAGE(PG8_SA(0, 1), a2 + hstepA, voffA);
            PG8_WAIT_V(8); PG8_WAIT_L(0); PG8_BAR; PG8_MMA(0, 0, At, B0); PG8_MMA(0, 1, At, B1); PG8_BAR; PG8_SCHED;
            PG8_LDA(At, 1, 1); PG8_STAGE(PG8_SB(1, 0), b3, voffB); PG8_STAGE(PG8_SB(1, 1), b3 + hstep, voffB); PG8_STAGE(PG8_SA(1, 0), a3, voffA);
            PG8_WAIT_V(8); PG8_WAIT_L(0); PG8_BAR; PG8_MMA(1, 0, At, B0); PG8_MMA(1, 1, At, B1); PG8_BAR; PG8_SCHED;
            } else {
            PG8_LDB(B0, 0, 0); PG8_SCHED; PG8_LDA(At, 0, 0); PG8_STAGE(PG8_SA(1, 1), a1 + hstepA, voffA);
            PG8_WAIT_L(8); PG8_BAR; PG8_WAIT_L(0); PG8_MMA(0, 0, At, B0); PG8_BAR; PG8_SCHED;
            PG8_LDB(B1, 0, 1); PG8_STAGE(PG8_SB(0, 0), b2, voffB);
            PG8_BAR; PG8_WAIT_L(0); PG8_MMA(0, 1, At, B1); PG8_BAR;
            PG8_LDA(At, 0, 1); PG8_STAGE(PG8_SA(0, 0), a2, voffA);
            PG8_BAR; PG8_WAIT_L(0); PG8_MMA(1, 0, At, B0); PG8_BAR; PG8_SCHED;
            PG8_STAGE(PG8_SB(0, 1), b2 + hstep, voffB);
            PG8_WAIT_V(6); PG8_BAR; PG8_MMA(1, 1, At, B1); PG8_BAR;
            PG8_LDB(B0, 1, 0); PG8_SCHED; PG8_LDA(At, 1, 0); PG8_STAGE(PG8_SA(0, 1), a2 + hstepA, voffA);
            PG8_WAIT_L(8); PG8_BAR; PG8_WAIT_L(0); PG8_MMA(0, 0, At, B0); PG8_BAR; PG8_SCHED;
            PG8_LDB(B1, 1, 1); PG8_STAGE(PG8_SB(1, 0), b3, voffB);
            PG8_BAR; PG8_WAIT_L(0); PG8_MMA(0, 1, At, B1); PG8_BAR;
            PG8_LDA(At, 1, 1); PG8_STAGE(PG8_SA(1, 0), a3, voffA);
            PG8_BAR; PG8_WAIT_L(0); PG8_MMA(1, 0, At, B0); PG8_BAR; PG8_SCHED;
            PG8_STAGE(PG8_SB(1, 1), b3 + hstep, voffB);
            PG8_WAIT_V(6); PG8_BAR; PG8_MMA(1, 1, At, B1); PG8_BAR;
            }
        }
        if constexpr (ALIGN_EPI) { if (wr == 0) PG8_BAR; }
        if constexpr (!Epi::AFTER_DRAIN) { E(acc, cur, wr, wc, fr, fq); S.done(cur); }
        if (!has_next) break;
        if constexpr (Epi::ACC_INIT) E.init(acc, nxt, wr, wc, fr, fq);
        else {
#pragma unroll
        for (int a = 0; a < 2; ++a)
#pragma unroll
            for (int b = 0; b < 2; ++b)
#pragma unroll
                for (int m = 0; m < 4; ++m)
#pragma unroll
                    for (int n = 0; n < 2; ++n) acc[a][b][m][n] = (f32x4){0.f, 0.f, 0.f, 0.f};
        }
        cur = nxt; cA = nA; cB = nB; ++ui;
        if constexpr (ALIGN_EPI) { if (wr == 1) PG8_BAR; }
    }
    PG8_WAIT_V(0);
    if constexpr (!ALIGN_EPI) { if (wr == 0) PG8_BAR; }
    PG8_BAR;
    if constexpr (Epi::AFTER_DRAIN) { E.fused(acc, cur, wr, wc, fr, fq, lds, wid, lane); S.done(cur); }
#undef PG8_SA
#undef PG8_SB
#undef PG8_STAGE
#undef PG8_LDA
#undef PG8_LDB
#undef PG8_MMA
#undef PG8_WAIT_V
#undef PG8_WAIT_L
#undef PG8_BAR
#undef PG8_SCHED
}
}

#define LAS __attribute__((address_space(3)))
typedef unsigned short bf16;
typedef unsigned v4u __attribute__((ext_vector_type(4)));
typedef unsigned v2u __attribute__((ext_vector_type(2)));
typedef float f32x4 __attribute__((ext_vector_type(4)));
typedef float f32x2 __attribute__((ext_vector_type(2)));
typedef short bf16x8 __attribute__((ext_vector_type(8)));
typedef short s16x4 __attribute__((ext_vector_type(4)));
using pg8::cvt_pk_bf16;

constexpr int M = 16384, D = 1024, FF = 2816, SEQ = 4096, NH = 4;
constexpr float EPS = 1e-6f;
constexpr size_t MiB = 1u << 20;
constexpr size_t WS_STAT = 0;
constexpr size_t WS_CNT = 320 * 1024;
static_assert(WS_CNT == (size_t)5 * 16384 * 4, "counters directly above the statistics");
constexpr size_t WS_BAR = 400 * 1024;
constexpr size_t HMiB = 512 * 1024;
constexpr size_t WS_TAB = 1 * HMiB;
constexpr size_t WS_WA = 9 * HMiB, WS_WB = 13 * HMiB, WS_WO = 17 * HMiB;
constexpr size_t WS_WIN = 21 * HMiB;
constexpr size_t WS_XB = 53 * HMiB;
constexpr size_t WS_G = 117 * HMiB;
constexpr size_t SLOT = 32 * MiB;
constexpr size_t WS_S0 = WS_G, WS_S1 = WS_G + SLOT, WS_S2 = WS_G + 2 * SLOT, WS_S3 = WS_G + 3 * SLOT, WS_S4 = WS_G + 4 * SLOT, WS_S5 = WS_G + 5 * SLOT;
constexpr size_t WS_ACT = WS_G;
constexpr size_t WS_WGU = 437 * HMiB;
constexpr size_t WS_WD = 459 * HMiB;
constexpr size_t WS_WD2 = 501 * HMiB;
static_assert(WS_S5 + SLOT <= WS_WD2 && WS_WD2 + (size_t)D * FF * 2 <= 256 * MiB && WS_WD + (size_t)D * FF * 2 <= WS_S5 + SLOT && WS_ACT + (size_t)M * FF * 2 <= WS_WGU && WS_WGU >= WS_S5, "ws map");
constexpr int LDS_BYTES = 147456;

__device__ __forceinline__ float bflo(unsigned w) { return __uint_as_float(w << 16); }
__device__ __forceinline__ float bfhi(unsigned w) { return __uint_as_float(w & 0xffff0000u); }
__device__ __forceinline__ float sigmoidf_(float x) { return __builtin_amdgcn_rcpf(1.f + __builtin_amdgcn_exp2f(-1.44269504f * x)); }
__device__ __forceinline__ float siluf_(float x) { return x * sigmoidf_(x); }
#define LDS_WAIT() asm volatile("s_waitcnt lgkmcnt(0)" ::: "memory")

struct EpiSwiGLU {
    static constexpr bool PERM = true, AFTER_DRAIN = false, ACC_INIT = false;
    bf16* O; const float* rowss;
    mutable float rc0, rc1, rc2, rc3, rc4, rc5, rc6, rc7; mutable int pmc;
    __device__ __forceinline__ void operator()(const f32x4 (&acc)[2][2][4][2], const pg8::Unit& u, int wr, int wc, int fr, int fq) const {
        const int row0 = u.pm * 256 + wr * 64 + fr, col0 = u.pn * 128 + wc * 32 + 8 * fq;
        if (rowss && u.pm != pmc) {
#define RSQ_(k_) __builtin_amdgcn_rsqf(rowss[row0 + ((k_) >> 2) * 128 + ((k_) & 3) * 16] * (1.f / 1024.f) + EPS)
            rc0 = RSQ_(0); rc1 = RSQ_(1); rc2 = RSQ_(2); rc3 = RSQ_(3); rc4 = RSQ_(4); rc5 = RSQ_(5); rc6 = RSQ_(6); rc7 = RSQ_(7);
#undef RSQ_
            pmc = u.pm;
        }
#pragma unroll
        for (int ai = 0; ai < 2; ++ai)
#pragma unroll
            for (int m = 0; m < 4; ++m) {
                const int row = row0 + ai * 128 + m * 16;
                const float rs = rowss ? (ai == 0 ? (m == 0 ? rc0 : m == 1 ? rc1 : m == 2 ? rc2 : rc3) : (m == 0 ? rc4 : m == 1 ? rc5 : m == 2 ? rc6 : rc7)) : 1.f;
                float o[8];
#pragma unroll
                for (int n = 0; n < 2; ++n)
#pragma unroll
                    for (int j = 0; j < 4; ++j) { const float g = acc[ai][0][m][n][j] * rs, up = acc[ai][1][m][n][j] * rs; o[n * 4 + j] = siluf_(g) * up; }
                v4u w; w.x = cvt_pk_bf16(o[0], o[1]); w.y = cvt_pk_bf16(o[2], o[3]); w.z = cvt_pk_bf16(o[4], o[5]); w.w = cvt_pk_bf16(o[6], o[7]);
                *(v4u*)(O + ((size_t)((row >> 8) * (FF / 64) + (col0 >> 6)) * 256 + (row & 255)) * 64 + (col0 & 63)) = w;
            }
    }
};
struct EpiResid {
    static constexpr bool PERM = true, AFTER_DRAIN = false, ACC_INIT = true;
    const bf16* resb; float* out; bf16* xb; float* rowss; float scale;
    __device__ __forceinline__ void init(f32x4 (&acc)[2][2][4][2], const pg8::Unit& u, int wr, int wc, int fr, int fq) const {
        const int row0 = u.pm * 256 + wr * 64 + fr, col0 = u.pn * 256 + wc * 32 + 8 * fq; const float is = 1.f / scale;
#pragma unroll
        for (int ai = 0; ai < 2; ++ai)
#pragma unroll
            for (int m = 0; m < 4; ++m)
#pragma unroll
                for (int bj = 0; bj < 2; ++bj) {
                    const v4u rb = *(const v4u*)(resb + (size_t)(row0 + ai * 128 + m * 16) * D + col0 + bj * 128);
                    acc[ai][bj][m][0] = (f32x4){bflo(rb.x) * is, bfhi(rb.x) * is, bflo(rb.y) * is, bfhi(rb.y) * is};
                    acc[ai][bj][m][1] = (f32x4){bflo(rb.z) * is, bfhi(rb.z) * is, bflo(rb.w) * is, bfhi(rb.w) * is};
                }
    }
    __device__ __forceinline__ void operator()(const f32x4 (&acc)[2][2][4][2], const pg8::Unit& u, int wr, int wc, int fr, int fq) const {
        const int row0 = u.pm * 256 + wr * 64 + fr, col0 = u.pn * 256 + wc * 32 + 8 * fq;
#pragma unroll
        for (int ai = 0; ai < 2; ++ai)
#pragma unroll
            for (int m = 0; m < 4; ++m) {
                const int row = row0 + ai * 128 + m * 16; float ss = 0.f;
#pragma unroll
                for (int bj = 0; bj < 2; ++bj) {
                    const size_t off = (size_t)row * D + col0 + bj * 128;
                    const f32x4 o0 = acc[ai][bj][m][0] * scale, o1 = acc[ai][bj][m][1] * scale;
                    if (out) { *(f32x4*)(out + off) = o0; *(f32x4*)(out + off + 4) = o1; }
                    ss += (o0[0] * o0[0] + o0[1] * o0[1]) + (o0[2] * o0[2] + o0[3] * o0[3]) + (o1[0] * o1[0] + o1[1] * o1[1]) + (o1[2] * o1[2] + o1[3] * o1[3]);
                    if (xb) { v4u w; w.x = cvt_pk_bf16(o0[0], o0[1]); w.y = cvt_pk_bf16(o0[2], o0[3]); w.z = cvt_pk_bf16(o1[0], o1[1]); w.w = cvt_pk_bf16(o1[2], o1[3]); *(v4u*)(xb + off) = w; }
                }
                if (rowss) { ss += __shfl_xor(ss, 16); ss += __shfl_xor(ss, 32); if (fq == 0) atomicAdd(rowss + row, ss); }
            }
    }
};
struct EpiFinal {
    static constexpr bool PERM = true, AFTER_DRAIN = false, ACC_INIT = true;
    const bf16* resb; float* rowss; unsigned* cnt; const float* gn; float* out;
    __device__ __forceinline__ void init(f32x4 (&acc)[2][2][4][2], const pg8::Unit& u, int wr, int wc, int fr, int fq) const {
        const int row0 = u.pm * 256 + wr * 64 + fr, col0 = u.pn * 256 + wc * 32 + 8 * fq;
#pragma unroll
        for (int ai = 0; ai < 2; ++ai)
#pragma unroll
            for (int m = 0; m < 4; ++m)
#pragma unroll
                for (int bj = 0; bj < 2; ++bj) {
                    const v4u rb = *(const v4u*)(resb + (size_t)(row0 + ai * 128 + m * 16) * D + col0 + bj * 128);
                    acc[ai][bj][m][0] = (f32x4){bflo(rb.x) * 2.f, bfhi(rb.x) * 2.f, bflo(rb.y) * 2.f, bfhi(rb.y) * 2.f};
                    acc[ai][bj][m][1] = (f32x4){bflo(rb.z) * 2.f, bfhi(rb.z) * 2.f, bflo(rb.w) * 2.f, bfhi(rb.w) * 2.f};
                }
    }
    __device__ __forceinline__ void operator()(const f32x4 (&acc)[2][2][4][2], const pg8::Unit& u, int wr, int wc, int fr, int fq) const {
        const int row0 = u.pm * 256 + wr * 64 + fr, col0 = u.pn * 256 + wc * 32 + 8 * fq;
#pragma unroll
        for (int ai = 0; ai < 2; ++ai)
#pragma unroll
            for (int m = 0; m < 4; ++m) {
                float ss = 0.f;
#pragma unroll
                for (int bj = 0; bj < 2; ++bj) { const f32x4 c0 = acc[ai][bj][m][0], c1 = acc[ai][bj][m][1];
                    ss += (c0[0] * c0[0] + c0[1] * c0[1]) + (c0[2] * c0[2] + c0[3] * c0[3]) + (c1[0] * c1[0] + c1[1] * c1[1]) + (c1[2] * c1[2] + c1[3] * c1[3]); }
                ss *= 0.25f;
                ss += __shfl_xor(ss, 16); ss += __shfl_xor(ss, 32);
                if (fq == 0) atomicAdd(rowss + row0 + ai * 128 + m * 16, ss);
            }
        asm volatile("s_waitcnt vmcnt(0)" ::: "memory");
        unsigned* c = cnt + 64 * u.pm;
        if ((threadIdx.x & 63) == 0) __hip_atomic_fetch_add(c, 1u, __ATOMIC_RELAXED, __HIP_MEMORY_SCOPE_AGENT);
        { unsigned spins = 0; while (__hip_atomic_load(c, __ATOMIC_RELAXED, __HIP_MEMORY_SCOPE_AGENT) < 32u && ++spins < (1u << 22)) __builtin_amdgcn_s_sleep(2); }
        asm volatile("" ::: "memory");
        float rsv[2][4];
#pragma unroll
        for (int ai = 0; ai < 2; ++ai)
#pragma unroll
            for (int m = 0; m < 4; ++m) rsv[ai][m] = 0.5f * __builtin_amdgcn_rsqf(__hip_atomic_load(rowss + row0 + ai * 128 + m * 16, __ATOMIC_RELAXED, __HIP_MEMORY_SCOPE_AGENT) * (1.f / D) + EPS);
        f32x4 g0[2], g1[2];
#pragma unroll
        for (int bj = 0; bj < 2; ++bj) { g0[bj] = *(const f32x4*)(gn + col0 + bj * 128); g1[bj] = *(const f32x4*)(gn + col0 + bj * 128 + 4); }
#pragma unroll
        for (int ai = 0; ai < 2; ++ai)
#pragma unroll
            for (int m = 0; m < 4; ++m) {
                const float rs = rsv[ai][m];
#pragma unroll
                for (int bj = 0; bj < 2; ++bj) {
                    const size_t off = (size_t)(row0 + ai * 128 + m * 16) * D + col0 + bj * 128;
                    *(f32x4*)(out + off) = acc[ai][bj][m][0] * rs * g0[bj];
                    *(f32x4*)(out + off + 4) = acc[ai][bj][m][1] * rs * g1[bj];
                }
            }
    }
};
struct EpiBranch {
    static constexpr bool PERM = true, AFTER_DRAIN = false, ACC_INIT = false;
    const bf16* gate; const bf16* add; bf16* out;
    __device__ __forceinline__ void operator()(const f32x4 (&acc)[2][2][4][2], const pg8::Unit& u, int wr, int wc, int fr, int fq) const {
        const int row0 = u.pm * 256 + wr * 64 + fr, col0 = u.pn * 256 + wc * 32 + 8 * fq;
#pragma unroll
        for (int ai = 0; ai < 2; ++ai) {
            v4u gv[4][2], av[4][2];
#pragma unroll
            for (int m = 0; m < 4; ++m)
#pragma unroll
                for (int bj = 0; bj < 2; ++bj) {
                    const size_t off = (size_t)(row0 + ai * 128 + m * 16) * D + col0 + bj * 128;
                    gv[m][bj] = *(const v4u*)(gate + off); av[m][bj] = add ? *(const v4u*)(add + off) : (v4u){0u, 0u, 0u, 0u};
                }
#pragma unroll
            for (int m = 0; m < 4; ++m)
#pragma unroll
                for (int bj = 0; bj < 2; ++bj) {
                    const size_t off = (size_t)(row0 + ai * 128 + m * 16) * D + col0 + bj * 128;
                    const v4u g = gv[m][bj], a = av[m][bj];
                    const f32x4 c0 = acc[ai][bj][m][0], c1 = acc[ai][bj][m][1];
                    float gf[8] = {bflo(g.x), bfhi(g.x), bflo(g.y), bfhi(g.y), bflo(g.z), bfhi(g.z), bflo(g.w), bfhi(g.w)};
#pragma unroll
                    for (int e = 0; e < 8; ++e) gf[e] = sigmoidf_(gf[e]);
                    v4u w;
                    w.x = cvt_pk_bf16(bflo(a.x) + gf[0] * c0[0], bfhi(a.x) + gf[1] * c0[1]);
                    w.y = cvt_pk_bf16(bflo(a.y) + gf[2] * c0[2], bfhi(a.y) + gf[3] * c0[3]);
                    w.z = cvt_pk_bf16(bflo(a.z) + gf[4] * c1[0], bfhi(a.z) + gf[5] * c1[1]);
                    w.w = cvt_pk_bf16(bflo(a.w) + gf[6] * c1[2], bfhi(a.w) + gf[7] * c1[3]);
                    *(v4u*)(out + off) = w;
                }
            asm volatile("" ::: "memory");
        }
    }
};
struct EpiInProj {
    static constexpr bool PERM = true, AFTER_DRAIN = false, ACC_INIT = false;
    const float* rowss; const float* bias; unsigned char* ws; float* vsum; float* vsumsq; const float* tcos; const float* tsin; int tile0; bf16* qout;
    mutable float rc0, rc1, rc2, rc3, rc4, rc5, rc6, rc7; mutable int pmc;
    __device__ __forceinline__ void operator()(const f32x4 (&acc)[2][2][4][2], const pg8::Unit& u, int wr, int wc, int fr, int fq) const {
        const int pn = u.pn + tile0, seg = pn >> 2, sub = pn & 3;
        const int oseg = seg == 0 ? 0 : seg == 1 ? 1 : seg == 2 ? 6 : seg == 3 ? 2 : seg == 4 ? 3 : seg == 5 ? 4 : seg == 6 ? 5 : 7;
        const size_t soff = seg == 0 ? WS_S0 : seg == 1 ? WS_S1 : seg == 2 ? WS_S2 : seg == 3 ? WS_S0 : seg == 4 ? WS_S1 : seg == 5 ? WS_S3 : seg == 6 ? WS_S4 : WS_S5;
        bf16* O = seg == 3 ? qout : (bf16*)(ws + soff);
        const int row0 = u.pm * 256 + wr * 64 + fr, lc = wc * 32 + 8 * fq, col0 = sub * 256 + lc;
        const float* bp = bias + oseg * 1024 + col0;
        f32x4 bv[2][2];
#pragma unroll
        for (int bj = 0; bj < 2; ++bj)
#pragma unroll
            for (int n = 0; n < 2; ++n) bv[bj][n] = *(const f32x4*)(bp + bj * 128 + 4 * n);
        if (u.pm != pmc) {
#define RSQ_(k_) __builtin_amdgcn_rsqf(rowss[row0 + ((k_) >> 2) * 128 + ((k_) & 3) * 16] * (1.f / 1024.f) + EPS)
            rc0 = RSQ_(0); rc1 = RSQ_(1); rc2 = RSQ_(2); rc3 = RSQ_(3); rc4 = RSQ_(4); rc5 = RSQ_(5); rc6 = RSQ_(6); rc7 = RSQ_(7);
#undef RSQ_
            pmc = u.pm;
        }
        const bool rot = (seg == 3 || seg == 4);
#pragma unroll
        for (int ai = 0; ai < 2; ++ai) {
            f32x4 tc[4][2], tsv[4][2];
#pragma unroll
            for (int mh = 0; mh < 2; ++mh) {
            if (rot) {
#pragma unroll
                for (int m = 2 * mh; m < 2 * mh + 2; ++m)
#pragma unroll
                    for (int n = 0; n < 2; ++n) { const int pos = (row0 + ai * 128 + m * 16) & (SEQ - 1); tc[m][n] = *(const f32x4*)(tcos + pos * 128 + lc + 4 * n); tsv[m][n] = *(const f32x4*)(tsin + pos * 128 + lc + 4 * n); }
            }
#pragma unroll
            for (int m = 2 * mh; m < 2 * mh + 2; ++m) {
                const int row = row0 + ai * 128 + m * 16;
                const float rs = (ai == 0 ? (m == 0 ? rc0 : m == 1 ? rc1 : m == 2 ? rc2 : rc3) : (m == 0 ? rc4 : m == 1 ? rc5 : m == 2 ? rc6 : rc7));
                f32x4 v[2][2];
#pragma unroll
                for (int bj = 0; bj < 2; ++bj)
#pragma unroll
                    for (int n = 0; n < 2; ++n) v[bj][n] = acc[ai][bj][m][n] * rs + bv[bj][n];
                if (rot) {
                    const float ks = seg == 4 ? 0.0625f : 1.f;
#pragma unroll
                    for (int n = 0; n < 2; ++n) {
                        const f32x4 c = tc[m][n], s = tsv[m][n];
                        const f32x4 a = v[0][n], b = v[1][n];
                        v[0][n] = (a * c - b * s) * ks; v[1][n] = (b * c + a * s) * ks;
                    }
                } else if (seg == 1) {
#pragma unroll
                    for (int bj = 0; bj < 2; ++bj)
#pragma unroll
                        for (int n = 0; n < 2; ++n) { const f32x2 a = pg8::gelu_pk((f32x2){v[bj][n][0], v[bj][n][1]}), b = pg8::gelu_pk((f32x2){v[bj][n][2], v[bj][n][3]}); v[bj][n] = (f32x4){a.x, a.y, b.x, b.y}; }
                    if (seg == 1) {
                        float s1 = 0.f, s2 = 0.f;
#pragma unroll
                        for (int bj = 0; bj < 2; ++bj)
#pragma unroll
                            for (int n = 0; n < 2; ++n)
#pragma unroll
                                for (int j = 0; j < 4; ++j) { s1 += v[bj][n][j]; s2 += v[bj][n][j] * v[bj][n][j]; }
                        s1 += __shfl_xor(s1, 16); s1 += __shfl_xor(s1, 32); s2 += __shfl_xor(s2, 16); s2 += __shfl_xor(s2, 32);
                        if (fq == 0) { atomicAdd(vsum + row, s1); atomicAdd(vsumsq + row, s2); }
                    }
                }
#pragma unroll
                for (int bj = 0; bj < 2; ++bj) {
                    v4u w; w.x = cvt_pk_bf16(v[bj][0][0], v[bj][0][1]); w.y = cvt_pk_bf16(v[bj][0][2], v[bj][0][3]); w.z = cvt_pk_bf16(v[bj][1][0], v[bj][1][1]); w.w = cvt_pk_bf16(v[bj][1][2], v[bj][1][3]);
                    *(v4u*)(O + (size_t)row * D + col0 + bj * 128) = w;
                }
            }
            asm volatile("" ::: "memory");
            }
        }
    }
};

__device__ __forceinline__ float wave_sum(float v) {
#pragma unroll
    for (int o = 1; o < 64; o <<= 1) v += __shfl_xor(v, o);
    return v;
}
struct Ctx { const float* in[21]; float* out; unsigned char* ws; };
__device__ __forceinline__ int dest_row(int mode, int n0) {
    if (mode == 1) return 256 * (n0 >> 7) + (n0 & 127);
    if (mode == 2) return 256 * (n0 >> 7) + 128 + (n0 & 127);
    if (mode == 3) { const int os = n0 >> 10; const int ns = os == 0 ? 0 : os == 1 ? 1 : os == 2 ? 3 : os == 3 ? 4 : os == 4 ? 5 : os == 5 ? 6 : os == 6 ? 2 : 7; return ns * 1024 + (n0 & 1023); }
    return n0;
}
struct TJob { const float* W; bf16* WT; const float* ks; int K, N, mode, it; };
__device__ __forceinline__ TJob tjob(const Ctx& C, int list, int g) {
    unsigned char* ws = C.ws; unsigned char* ob = (unsigned char*)C.out; TJob j;
    if (list == 0) {
        if (g < 176)       { j.W = C.in[2];  j.WT = (bf16*)(ws + WS_WGU); j.ks = nullptr; j.K = D;  j.N = FF;    j.mode = 1; j.it = g; }
        else if (g < 352)  { j.W = C.in[3];  j.WT = (bf16*)(ws + WS_WGU); j.ks = nullptr; j.K = D;  j.N = FF;    j.mode = 2; j.it = g - 176; }
        else if (g < 528)  { j.W = C.in[4];  j.WT = (bf16*)(ws + WS_WD);  j.ks = nullptr; j.K = FF; j.N = D;     j.mode = 0; j.it = g - 352; }
        else if (g < 1040) { j.W = C.in[6];  j.WT = (bf16*)(ws + WS_WIN); j.ks = C.in[5]; j.K = D;  j.N = 8 * D; j.mode = 3; j.it = g - 528; }
        else if (g < 1104) { j.W = C.in[13]; j.WT = (bf16*)(ws + WS_WA);  j.ks = nullptr; j.K = D;  j.N = D;     j.mode = 0; j.it = g - 1040; }
        else if (g < 1168) { j.W = C.in[14]; j.WT = (bf16*)(ws + WS_WB);  j.ks = nullptr; j.K = D;  j.N = D;     j.mode = 0; j.it = g - 1104; }
        else               { j.W = C.in[15]; j.WT = (bf16*)(ws + WS_WO);  j.ks = nullptr; j.K = D;  j.N = D;     j.mode = 0; j.it = g - 1168; }
    } else {
        if (g < 176)       { j.W = C.in[17]; j.WT = (bf16*)(ob + 32 * MiB); j.ks = C.in[16]; j.K = D;  j.N = FF; j.mode = 1; j.it = g; }
        else if (g < 352)  { j.W = C.in[18]; j.WT = (bf16*)(ob + 32 * MiB); j.ks = C.in[16]; j.K = D;  j.N = FF; j.mode = 2; j.it = g - 176; }
        else               { j.W = C.in[19]; j.WT = (bf16*)(ws + WS_WD2);  j.ks = nullptr;  j.K = FF; j.N = D;  j.mode = 0; j.it = g - 352; }
    }
    return j;
}
__device__ __forceinline__ void transpose_list(const Ctx& C, int list, int total, LAS unsigned char* img, int cb, int ncb, int tid, int wave, int lane) {
    const int g = lane >> 4, q = (lane & 15) >> 2, p = lane & 3;
    int it = cb; if (it >= total) return;
    TJob J = tjob(C, list, it);
    f32x4 v[8];
    { const int nblk = J.N / 256, k0 = 64 * (J.it / nblk), n0 = 256 * (J.it % nblk);
#pragma unroll
      for (int i = 0; i < 8; ++i) v[i] = __builtin_nontemporal_load((const f32x4*)(J.W + (size_t)(k0 + wave + 8 * i) * J.N + n0 + 4 * lane)); }
    for (;;) {
        const int nblk = J.N / 256, k0 = 64 * (J.it / nblk), n0 = 256 * (J.it % nblk);
        __syncthreads();
#pragma unroll
        for (int i = 0; i < 8; ++i) { const float s = J.ks ? J.ks[k0 + wave + 8 * i] : 1.f; v2u w; w.x = cvt_pk_bf16(v[i][0] * s, v[i][1] * s); w.y = cvt_pk_bf16(v[i][2] * s, v[i][3] * s);
            *(LAS v2u*)(img + (wave + 8 * i) * 544 + 8 * lane) = w; }
        const int nit = it + ncb; TJob Jn = J;
        if (nit < total) { Jn = tjob(C, list, nit); const int nb2 = Jn.N / 256, k2 = 64 * (Jn.it / nb2), n2 = 256 * (Jn.it % nb2);
#pragma unroll
            for (int i = 0; i < 8; ++i) v[i] = __builtin_nontemporal_load((const f32x4*)(Jn.W + (size_t)(k2 + wave + 8 * i) * Jn.N + n2 + 4 * lane)); }
        __syncthreads();
#pragma unroll
        for (int j = 0; j < 4; ++j) {
            const int blk = wave * 4 + j, kh = blk & 1, nb = blk >> 1;
            const LAS unsigned char* a = img + (32 * kh + 8 * g + q) * 544 + (16 * nb + 4 * p) * 2;
            const s16x4 lo = __builtin_amdgcn_ds_read_tr16_b64_v4i16((LAS s16x4*)a);
            const s16x4 hi = __builtin_amdgcn_ds_read_tr16_b64_v4i16((LAS s16x4*)(a + 4 * 544));
            const bf16x8 o = __builtin_shufflevector(lo, hi, 0, 1, 2, 3, 4, 5, 6, 7);
            *(bf16x8*)(J.WT + (size_t)(dest_row(J.mode, n0 + 16 * nb) + (lane & 15)) * J.K + k0 + 32 * kh + 8 * g) = o;
        }
        if (nit >= total) break;
        it = nit; J = Jn;
    }
}
__device__ __forceinline__ bf16x8 tr_frag(const LAS unsigned char* img, int stride, int tok0, int ch0, int lane) {
    const int g = lane >> 4, q = (lane & 15) >> 2, p = lane & 3;
    const LAS unsigned char* a = img + (tok0 + 4 * g + q) * stride + (ch0 + 4 * p) * 2;
    const s16x4 lo = __builtin_amdgcn_ds_read_tr16_b64_v4i16((LAS s16x4*)a);
    const s16x4 hi = __builtin_amdgcn_ds_read_tr16_b64_v4i16((LAS s16x4*)(a + 16 * stride));
    return __builtin_shufflevector(lo, hi, 0, 1, 2, 3, 4, 5, 6, 7);
}
#define MFMA16(a, b, c) __builtin_amdgcn_mfma_f32_16x16x32_bf16((a), (b), (c), 0, 0, 0)
constexpr int IMG = 544;
constexpr int IMGH = 288;


__device__ __forceinline__ void p0_prologue(const Ctx& C, LAS unsigned char* lds, int tid, int wave, int lane) {
    asm volatile("" : "+v"(tid)); wave = __builtin_amdgcn_readfirstlane(tid >> 6); lane = tid & 63;
    const int G = gridDim.x, gw = blockIdx.x * 8 + wave, ngw = G * 8, gt = blockIdx.x * 512 + tid, ngt = G * 512;
    unsigned char* ws = C.ws;
    float* st = (float*)(ws + WS_STAT);
    for (int i = gt; i < 5 * M + 4096; i += ngt) st[i] = 0.f;
    float* tc = (float*)(ws + WS_TAB); float* tsn = tc + SEQ * 128;
    {
        const int fi = gt & 127;
        const float th = powf(10000.f, -(float)(2 * fi) / 256.f);
        for (int i = gt; i < SEQ * 128; i += ngt) { const int pos = i >> 7; const float ang = (float)pos * th, k = rintf(ang * 0.15915494309f);
            float r = fmaf(-k, 6.2831854820251465f, ang); r = fmaf(-k, -1.7484555e-7f, r); const float xr = r * 0.15915494309f;
            tc[i] = __builtin_amdgcn_cosf(xr); tsn[i] = __builtin_amdgcn_sinf(xr); }
    }
    transpose_list(C, 0, 1232, lds, (int)blockIdx.x, G, tid, wave, lane);
    const float* x = C.in[0]; const float* gn = C.in[1]; bf16* xb = (bf16*)(ws + WS_XB); bf16* x16 = (bf16*)(ws + WS_S3);
    for (int m = gw; m < M; m += 2 * ngw) {
        const int m2 = (m + ngw < M) ? m + ngw : m;
        const f32x4* xr = (const f32x4*)(x + (size_t)m * D) + lane; const f32x4* xr2 = (const f32x4*)(x + (size_t)m2 * D) + lane; f32x4 v[4], v2[4]; float s = 0.f, s2 = 0.f;
#pragma unroll
        for (int j = 0; j < 4; ++j) { v[j] = __builtin_nontemporal_load(xr + 64 * j); v2[j] = __builtin_nontemporal_load(xr2 + 64 * j); }
#pragma unroll
        for (int j = 0; j < 4; ++j) { s += (v[j][0] * v[j][0] + v[j][1] * v[j][1]) + (v[j][2] * v[j][2] + v[j][3] * v[j][3]); s2 += (v2[j][0] * v2[j][0] + v2[j][1] * v2[j][1]) + (v2[j][2] * v2[j][2] + v2[j][3] * v2[j][3]); }
        const float rs = __builtin_amdgcn_rsqf(wave_sum(s) * (1.f / D) + EPS), rs2 = __builtin_amdgcn_rsqf(wave_sum(s2) * (1.f / D) + EPS);
#pragma unroll
        for (int j = 0; j < 4; ++j) { const f32x4 g = ((const f32x4*)gn)[lane + 64 * j]; const f32x4 o = v[j] * rs * g, o2 = v2[j] * rs2 * g;
            v2u w; w.x = cvt_pk_bf16(o[0], o[1]); w.y = cvt_pk_bf16(o[2], o[3]); ((v2u*)(xb + (size_t)m * D))[lane + 64 * j] = w;
            v2u w2; w2.x = cvt_pk_bf16(o2[0], o2[1]); w2.y = cvt_pk_bf16(o2[2], o2[3]); ((v2u*)(xb + (size_t)m2 * D))[lane + 64 * j] = w2;
            v2u r; r.x = cvt_pk_bf16(v[j][0], v[j][1]); r.y = cvt_pk_bf16(v[j][2], v[j][3]); ((v2u*)(x16 + (size_t)m * D))[lane + 64 * j] = r;
            v2u r2; r2.x = cvt_pk_bf16(v2[j][0], v2[j][1]); r2.y = cvt_pk_bf16(v2[j][2], v2[j][3]); ((v2u*)(x16 + (size_t)m2 * D))[lane + 64 * j] = r2; }
    }
}

constexpr size_t OUT_WGU2 = 32 * MiB;
__device__ __forceinline__ void convert_rest(const Ctx& C, LAS unsigned char* lds, int cb, int ncb, int tid, int wave, int lane) {
    asm volatile("" : "+v"(tid)); wave = __builtin_amdgcn_readfirstlane(tid >> 6); lane = tid & 63;
    transpose_list(C, 1, 528, lds, cb, ncb, tid, wave, lane);
}

__device__ __forceinline__ void sgu_phase(const Ctx& C, LAS unsigned char* lds, int tid, int wave, int lane) {
    asm volatile("" : "+v"(tid)); wave = __builtin_amdgcn_readfirstlane(tid >> 6); lane = tid & 63;
    const int fr = lane & 15, fq = lane >> 4;
    unsigned char* ws = C.ws;
    bf16* U = (bf16*)(ws + WS_S0); const bf16* V = (const bf16*)(ws + WS_S1);
    const float* vsum = (const float*)(ws + WS_STAT) + 2 * M; const float* vsumsq = vsum + M;
    const float* ng = C.in[8]; const float* nb = C.in[9]; const float* Wsp = C.in[10]; const float* bsp = C.in[11];
    for (int unit = blockIdx.x; unit < 512; unit += gridDim.x) {
        const int g = unit & 3, m0 = (unit >> 2) * 128, d0 = g * 256;
        __syncthreads();
#pragma unroll
        for (int i = 0; i < 8; ++i) {
            const int idx = tid + 512 * i, tok = idx >> 5, c8 = idx & 31;
            const v4u raw = *(const v4u*)(V + (size_t)(m0 + tok) * D + d0 + c8 * 8);
            const float mu = vsum[m0 + tok] * (1.f / 1024.f), var = vsumsq[m0 + tok] * (1.f / 1024.f) - mu * mu, rs = __builtin_amdgcn_rsqf(var + EPS);
            const f32x4 g0 = *(const f32x4*)(ng + d0 + c8 * 8), g1 = *(const f32x4*)(ng + d0 + c8 * 8 + 4), b0 = *(const f32x4*)(nb + d0 + c8 * 8), b1 = *(const f32x4*)(nb + d0 + c8 * 8 + 4);
            v4u w;
            w.x = cvt_pk_bf16((bflo(raw.x) - mu) * rs * g0[0] + b0[0], (bfhi(raw.x) - mu) * rs * g0[1] + b0[1]);
            w.y = cvt_pk_bf16((bflo(raw.y) - mu) * rs * g0[2] + b0[2], (bfhi(raw.y) - mu) * rs * g0[3] + b0[3]);
            w.z = cvt_pk_bf16((bflo(raw.z) - mu) * rs * g1[0] + b1[0], (bfhi(raw.z) - mu) * rs * g1[1] + b1[1]);
            w.w = cvt_pk_bf16((bflo(raw.w) - mu) * rs * g1[2] + b1[2], (bfhi(raw.w) - mu) * rs * g1[3] + b1[3]);
            *(LAS v4u*)(lds + tok * IMG + c8 * 16) = w;
        }
        __syncthreads();
        const int c = wave * 16 + fr;
        bf16x8 wf[4];
#pragma unroll
        for (int kk = 0; kk < 4; ++kk) {
            const float* wp = Wsp + ((size_t)g * 128 + c) * 128 + 32 * kk + 4 * fq;
            const f32x4 a = *(const f32x4*)wp, b = *(const f32x4*)(wp + 16);
            v4u w; w.x = cvt_pk_bf16(a[0], a[1]); w.y = cvt_pk_bf16(a[2], a[3]); w.z = cvt_pk_bf16(b[0], b[1]); w.w = cvt_pk_bf16(b[2], b[3]);
            wf[kk] = __builtin_bit_cast(bf16x8, w);
        }
        f32x4 acc[16];
#pragma unroll
        for (int j = 0; j < 16; ++j) acc[j] = (f32x4){0.f, 0.f, 0.f, 0.f};
#pragma unroll
        for (int kk = 0; kk < 4; ++kk)
#pragma unroll
            for (int j = 0; j < 16; ++j) { const bf16x8 a = tr_frag(lds, IMG, 32 * kk, 16 * j, lane); acc[j] = MFMA16(a, wf[kk], acc[j]); }
        const float bsv = bsp[g * 128 + c];
        bf16* up = U + (size_t)(m0 + c) * D + d0 + 4 * fq;
#pragma unroll
        for (int j = 0; j < 16; ++j) {
            const v2u uu = *(const v2u*)(up + 16 * j);
            const f32x2 ga = pg8::gelu_pk((f32x2){bflo(uu.x), bfhi(uu.x)}), gb2 = pg8::gelu_pk((f32x2){bflo(uu.y), bfhi(uu.y)});
            v2u w; w.x = cvt_pk_bf16(ga.x * (acc[j][0] + bsv), ga.y * (acc[j][1] + bsv)); w.y = cvt_pk_bf16(gb2.x * (acc[j][2] + bsv), gb2.y * (acc[j][3] + bsv));
            *(v2u*)(up + 16 * j) = w;
        }
    }
}

__device__ __forceinline__ float lg2gamma(const float* logit, int dir, int h) { const float x = logit[dir * NH + h]; return -log1pf(expf(-x)) * 1.44269504f; }
constexpr int SC = 512;

constexpr int IMGQ = 160;
__device__ __forceinline__ void r1_phase(const Ctx& C, LAS unsigned char* lds, int tid, int wave, int lane) {
    asm volatile("" : "+v"(tid)); wave = __builtin_amdgcn_readfirstlane(tid >> 6); lane = tid & 63;
    const int fr = lane & 15, fq = lane >> 4, jw = wave & 3, ih = wave >> 2;
    unsigned char* ws = C.ws;
    const bf16* Kp = (const bf16*)(ws + WS_S1); const bf16* Vp = (const bf16*)(ws + WS_S3); bf16* ST = (bf16*)(ws + WS_S0);
    LAS unsigned char* kimg = lds; LAS unsigned char* vimg = lds + 128 * IMG;
    v4u pk[8], pv[2];
#define R1_LOAD(u_, s_) do { const int dvq_ = (u_) & 3, sc_ = ((u_) >> 2) & 7, bh_ = (u_) >> 5; const size_t t0_ = (size_t)(bh_ >> 2) * SEQ + sc_ * SC + (s_) * 128; const int h_ = bh_ & 3; \
        _Pragma("unroll") for (int i_ = 0; i_ < 8; ++i_) { const int idx_ = tid + 512 * i_; pk[i_] = *(const v4u*)(Kp + (t0_ + (idx_ >> 5)) * D + h_ * 256 + (idx_ & 31) * 8); } \
        _Pragma("unroll") for (int i_ = 0; i_ < 2; ++i_) { const int idx_ = tid + 512 * i_; pv[i_] = *(const v4u*)(Vp + (t0_ + (idx_ >> 3)) * D + h_ * 256 + dvq_ * 64 + (idx_ & 7) * 8); } } while (0)
    const int vcu = (gridDim.x % 8 == 0) ? (int)((blockIdx.x % 8) * (gridDim.x / 8) + blockIdx.x / 8) : (int)blockIdx.x;
    if (vcu < 512) R1_LOAD(vcu, 0);
    for (int unit = vcu; unit < 512; unit += gridDim.x) {
        const int dvq = unit & 3, sc = (unit >> 2) & 7, bh = unit >> 5, h = bh & 3;
        const float lgf = lg2gamma(C.in[12], 0, h), lgb = lg2gamma(C.in[12], 1, h);
        f32x4 acc[2][8];
#pragma unroll
        for (int d = 0; d < 2; ++d)
#pragma unroll
            for (int i = 0; i < 8; ++i) acc[d][i] = (f32x4){0.f, 0.f, 0.f, 0.f};
#pragma unroll 1
        for (int sub = 0; sub < 4; ++sub) {
            __syncthreads();
#pragma unroll
            for (int i = 0; i < 8; ++i) { const int idx = tid + 512 * i; *(LAS v4u*)(kimg + (idx >> 5) * IMG + (idx & 31) * 16) = pk[i]; }
#pragma unroll
            for (int i = 0; i < 2; ++i) { const int idx = tid + 512 * i; *(LAS v4u*)(vimg + (idx >> 3) * IMGQ + (idx & 7) * 16) = pv[i]; }
            __syncthreads();
            if (sub < 3) R1_LOAD(unit, sub + 1); else if (unit + (int)gridDim.x < 512) R1_LOAD(unit + (int)gridDim.x, 0);
#pragma unroll
            for (int kk = 0; kk < 4; ++kk) {
                const bf16x8 vr = tr_frag(vimg, IMGQ, 32 * kk, 16 * jw, lane);
                const v4u vw = __builtin_bit_cast(v4u, vr);
                float ve[8] = {bflo(vw.x), bfhi(vw.x), bflo(vw.y), bfhi(vw.y), bflo(vw.z), bfhi(vw.z), bflo(vw.w), bfhi(vw.w)};
                float of[8], ob[8];
#pragma unroll
                for (int e = 0; e < 8; ++e) { const int cc = sub * 128 + 32 * kk + 16 * (e >> 2) + 4 * fq + (e & 3);
                    of[e] = ve[e] * __builtin_amdgcn_exp2f((float)(SC - 1 - cc) * lgf); ob[e] = ve[e] * __builtin_amdgcn_exp2f((float)cc * lgb); }
                v4u wF, wB;
                wF.x = cvt_pk_bf16(of[0], of[1]); wF.y = cvt_pk_bf16(of[2], of[3]); wF.z = cvt_pk_bf16(of[4], of[5]); wF.w = cvt_pk_bf16(of[6], of[7]);
                wB.x = cvt_pk_bf16(ob[0], ob[1]); wB.y = cvt_pk_bf16(ob[2], ob[3]); wB.z = cvt_pk_bf16(ob[4], ob[5]); wB.w = cvt_pk_bf16(ob[6], ob[7]);
                const bf16x8 vF = __builtin_bit_cast(bf16x8, wF), vB = __builtin_bit_cast(bf16x8, wB);
#pragma unroll
                for (int i = 0; i < 8; ++i) { const bf16x8 kf = tr_frag(kimg, IMG, 32 * kk, 128 * ih + 16 * i, lane); acc[0][i] = MFMA16(kf, vF, acc[0][i]); acc[1][i] = MFMA16(kf, vB, acc[1][i]); }
            }
        }
#pragma unroll
        for (int d = 0; d < 2; ++d) {
            bf16* sp = ST + ((size_t)((bh * 2 + d) * 8 + sc) * 256 + dvq * 64 + 16 * jw + fr) * 256 + 128 * ih + 4 * fq;
#pragma unroll
            for (int i = 0; i < 8; ++i) { v2u w; w.x = cvt_pk_bf16(acc[d][i][0], acc[d][i][1]); w.y = cvt_pk_bf16(acc[d][i][2], acc[d][i][3]); *(v2u*)(sp + 16 * i) = w; }
        }
    }
}
__device__ __forceinline__ void r2_phase(const Ctx& C, int tid) {
    asm volatile("" : "+v"(tid));
    bf16* ST = (bf16*)(C.ws + WS_S0);
    const int gt = blockIdx.x * 512 + tid, ngt = gridDim.x * 512;
    for (int idx = gt; idx < 32 * 8192; idx += ngt) {
        const int e8 = idx & 8191, bd = idx >> 13, dir = bd & 1, h = (bd >> 1) & 3;
        const float cd = __builtin_amdgcn_exp2f((float)SC * lg2gamma(C.in[12], dir, h));
        v4u* base = (v4u*)(ST + (size_t)(bd * 8) * 65536 + e8 * 8);
        v4u raw[8];
#pragma unroll
        for (int s = 0; s < 8; ++s) raw[s] = base[(size_t)(dir ? 7 - s : s) * 8192];
        float carry[8];
#pragma unroll
        for (int e = 0; e < 8; ++e) carry[e] = 0.f;
#pragma unroll
        for (int s = 0; s < 8; ++s) {
            v4u w; w.x = cvt_pk_bf16(carry[0], carry[1]); w.y = cvt_pk_bf16(carry[2], carry[3]); w.z = cvt_pk_bf16(carry[4], carry[5]); w.w = cvt_pk_bf16(carry[6], carry[7]);
            base[(size_t)(dir ? 7 - s : s) * 8192] = w;
            const v4u r = raw[s];
            carry[0] = carry[0] * cd + bflo(r.x); carry[1] = carry[1] * cd + bfhi(r.x); carry[2] = carry[2] * cd + bflo(r.y); carry[3] = carry[3] * cd + bfhi(r.y);
            carry[4] = carry[4] * cd + bflo(r.z); carry[5] = carry[5] * cd + bfhi(r.z); carry[6] = carry[6] * cd + bflo(r.w); carry[7] = carry[7] * cd + bfhi(r.w);
        }
    }
}
__device__ __forceinline__ void stage64(LAS unsigned char* img, const bf16* src, size_t pitch, int tid) {
#pragma unroll
    for (int i = 0; i < 4; ++i) { const int idx = tid + 512 * i, r = idx >> 5, c8 = idx & 31; *(LAS v4u*)(img + r * IMG + c8 * 16) = *(const v4u*)(src + (size_t)r * pitch + c8 * 8); }
}
struct R3Src { const bf16* p0; const bf16* p1; int pitch; };
__device__ __forceinline__ R3Src r3_src(const bf16* ST, const bf16* Kp, const bf16* Vp, int unit, int s) {
    const int qb = unit & 31, bh = unit >> 5, b = bh >> 2, h = bh & 3, sc = qb >> 2;
    R3Src r;
    if (s < 4) { r.p0 = ST + ((size_t)((bh * 2 + 0) * 8 + sc) * 256 + 64 * s) * 256; r.p1 = ST + ((size_t)((bh * 2 + 1) * 8 + sc) * 256 + 64 * s) * 256; r.pitch = 256; }
    else { const size_t k0 = (size_t)b * SEQ + sc * SC + (s - 4) * 64; r.p0 = Kp + k0 * D + h * 256; r.p1 = Vp + k0 * D + h * 256; r.pitch = D; }
    return r;
}
constexpr int R3_TILE = 64 * IMG, R3_SET = 2 * R3_TILE;
#define R3_DMA(sp, setp) do { const int pb_ = (sp).pitch * 2; _Pragma("unroll") for (int i_ = 0; i_ < 5; ++i_) { if (i_ < 4 || wave < 2) { const int n_ = wave + 8 * i_; \
        __builtin_amdgcn_global_load_lds((const unsigned*)((const char*)(sp).p0 + (size_t)(drow[i_] * pb_ + dcb[i_])), (LAS unsigned*)((setp) + 1024 * n_), 16, 0, 0); \
        __builtin_amdgcn_global_load_lds((const unsigned*)((const char*)(sp).p1 + (size_t)(drow[i_] * pb_ + dcb[i_])), (LAS unsigned*)((setp) + R3_TILE + 1024 * n_), 16, 0, 0); } } } while (0)
#define R3_WAIT() asm volatile("s_waitcnt vmcnt(0)" ::: "memory")
__device__ __forceinline__ void r3_phase(const Ctx& C, LAS unsigned char* lds, int tid, int wave, int lane) {
    asm volatile("" : "+v"(tid)); wave = __builtin_amdgcn_readfirstlane(tid >> 6); lane = tid & 63;
    const int fr = lane & 15, fq = lane >> 4;
    int drow[5], dcb[5];
#pragma unroll
    for (int i = 0; i < 5; ++i) { const int o = 1024 * (wave + 8 * i) + 16 * lane, cb = o % IMG; drow[i] = o / IMG; dcb[i] = cb < 512 ? cb : 0; }
    unsigned char* ws = C.ws;
    bf16* Qp = (bf16*)C.out; const bf16* Kp = (const bf16*)(ws + WS_S1); const bf16* Vp = (const bf16*)(ws + WS_S3); const bf16* Gp = (const bf16*)(ws + WS_S4); const bf16* ST = (const bf16*)(ws + WS_S0);
    int unit = (gridDim.x % 8 == 0) ? (int)((blockIdx.x % 8) * (gridDim.x / 8) + blockIdx.x / 8) : (int)blockIdx.x;
    if (unit < 512) { const R3Src sp = r3_src(ST, Kp, Vp, unit, 0); __syncthreads(); R3_DMA(sp, lds); R3_WAIT(); __syncthreads(); }
    for (; unit < 512; unit += gridDim.x) {
        const int nunit = unit + gridDim.x;
        const int qb = unit & 31, bh = unit >> 5, b = bh >> 2, h = bh & 3;
        const float lgf = lg2gamma(C.in[12], 0, h), lgb = lg2gamma(C.in[12], 1, h);
        const size_t row = (size_t)b * SEQ + qb * 128 + 16 * wave + fr;
        const int ccq = (qb & 3) * 128 + 16 * wave + fr;
        bf16x8 qf[8];
#pragma unroll
        for (int kk = 0; kk < 8; ++kk) qf[kk] = *(const bf16x8*)(Qp + row * D + h * 256 + 32 * kk + 8 * fq);
        f32x4 acc[16];
        const float ff = __builtin_amdgcn_exp2f((float)(ccq + 1) * lgf), fb = __builtin_amdgcn_exp2f((float)(SC - ccq) * lgb);
        float colF[16], colB[16];
#pragma unroll
        for (int e = 0; e < 16; ++e) { const int j = 16 * (e >> 2) + 4 * fq + (e & 3); colF[e] = __builtin_amdgcn_exp2f(-(float)j * lgf); colB[e] = __builtin_amdgcn_exp2f((float)j * lgb); }
        const int kbd = ((qb & 3) * 128 + 16 * wave) >> 6;
#pragma unroll
        for (int s = 0; s < 4; ++s) {
            { const R3Src sp = r3_src(ST, Kp, Vp, unit, s + 1); R3_DMA(sp, lds + ((s + 1) & 1) * R3_SET); }
            const LAS unsigned char* bK = lds + (s & 1) * R3_SET; const LAS unsigned char* bV = bK + R3_TILE;
            f32x4 tF[4], tB[4];
#pragma unroll
            for (int jj = 0; jj < 4; ++jj) { tF[jj] = (f32x4){0.f, 0.f, 0.f, 0.f}; tB[jj] = (f32x4){0.f, 0.f, 0.f, 0.f}; }
#pragma unroll
            for (int jj = 0; jj < 4; ++jj)
#pragma unroll
                for (int kk = 0; kk < 8; ++kk) {
                    const bf16x8 sf = *(const LAS bf16x8*)(bK + (16 * jj + fr) * IMG + (32 * kk + 8 * fq) * 2);
                    const bf16x8 sb = *(const LAS bf16x8*)(bV + (16 * jj + fr) * IMG + (32 * kk + 8 * fq) * 2);
                    tF[jj] = MFMA16(sf, qf[kk], tF[jj]); tB[jj] = MFMA16(sb, qf[kk], tB[jj]);
                }
#pragma unroll
            for (int jj = 0; jj < 4; ++jj) acc[4 * s + jj] = tF[jj] * ff + tB[jj] * fb;
            R3_WAIT();
            __syncthreads();
        }
#pragma unroll 1
        for (int kb = 0; kb < 8; ++kb) {
            const bool has_next = (kb < 7) || (nunit < 512);
            if (has_next) { const R3Src sp = (kb < 7) ? r3_src(ST, Kp, Vp, unit, kb + 5) : r3_src(ST, Kp, Vp, nunit, 0); R3_DMA(sp, lds + ((kb + 1) & 1) * R3_SET); }
            const LAS unsigned char* bK = lds + (kb & 1) * R3_SET; const LAS unsigned char* bV = bK + R3_TILE;
            f32x4 P[4];
#pragma unroll
            for (int mb = 0; mb < 4; ++mb) {
                P[mb] = (f32x4){0.f, 0.f, 0.f, 0.f};
#pragma unroll
                for (int kk = 0; kk < 8; ++kk) { const bf16x8 kf = *(const LAS bf16x8*)(bK + (16 * mb + fr) * IMG + (32 * kk + 8 * fq) * 2); P[mb] = MFMA16(kf, qf[kk], P[mb]); }
            }
            if (kb < kbd) {
                const float rf = __builtin_amdgcn_exp2f((float)(ccq - kb * 64) * lgf);
#pragma unroll
                for (int mb = 0; mb < 4; ++mb)
#pragma unroll
                    for (int r = 0; r < 4; ++r) P[mb][r] *= rf * colF[4 * mb + r];
            } else if (kb > kbd) {
                const float rb = __builtin_amdgcn_exp2f((float)(kb * 64 - ccq) * lgb);
#pragma unroll
                for (int mb = 0; mb < 4; ++mb)
#pragma unroll
                    for (int r = 0; r < 4; ++r) P[mb][r] *= rb * colB[4 * mb + r];
            } else {
#pragma unroll
                for (int mb = 0; mb < 4; ++mb)
#pragma unroll
                    for (int r = 0; r < 4; ++r) { const int dd = ccq - (kb * 64 + 16 * mb + 4 * fq + r); const float e = dd >= 0 ? (float)dd * lgf : (float)(-dd) * lgb; P[mb][r] *= __builtin_amdgcn_exp2f(e); }
            }
#pragma unroll
            for (int t2 = 0; t2 < 2; ++t2) {
                v4u w; w.x = cvt_pk_bf16(P[2 * t2][0], P[2 * t2][1]); w.y = cvt_pk_bf16(P[2 * t2][2], P[2 * t2][3]); w.z = cvt_pk_bf16(P[2 * t2 + 1][0], P[2 * t2 + 1][1]); w.w = cvt_pk_bf16(P[2 * t2 + 1][2], P[2 * t2 + 1][3]);
                const bf16x8 pf = __builtin_bit_cast(bf16x8, w);
#pragma unroll
                for (int j = 0; j < 16; ++j) { const bf16x8 vf = tr_frag(bV, IMG, 32 * t2, 16 * j, lane); acc[j] = MFMA16(vf, pf, acc[j]); }
            }
            R3_WAIT();
            __syncthreads();
        }
        float ss = 0.f;
#pragma unroll
        for (int j = 0; j < 16; ++j) ss += (acc[j][0] * acc[j][0] + acc[j][1] * acc[j][1]) + (acc[j][2] * acc[j][2] + acc[j][3] * acc[j][3]);
        ss += __shfl_xor(ss, 16); ss += __shfl_xor(ss, 32);
        const float rs = __builtin_amdgcn_rsqf(ss * (1.f / 256.f) + EPS);
        const size_t ob = row * D + h * 256 + 4 * fq;
#pragma unroll
        for (int j = 0; j < 16; ++j) {
            const v2u gg = *(const v2u*)(Gp + ob + 16 * j);
            v2u w; w.x = cvt_pk_bf16(acc[j][0] * rs * siluf_(bflo(gg.x)), acc[j][1] * rs * siluf_(bfhi(gg.x))); w.y = cvt_pk_bf16(acc[j][2] * rs * siluf_(bflo(gg.y)), acc[j][3] * rs * siluf_(bfhi(gg.y)));
            *(v2u*)(Qp + ob + 16 * j) = w;
        }
    }
}

#define XB_TMO      128
#define XB_XCNT(j)  (256  + 64 * (j))
#define XB_XSUB(j)  (1280 + 64 * (j))
#define XB_XGEN(j)  (2304 + 64 * (j))
#define XB_TOP      3328
#define XB_TOPGEN   3392
#define XCD_BAR_WORDS 3456
#define XB_SPIN_CAP (1u << 18)

__device__ __forceinline__ unsigned xb_ld(unsigned* p)              { return __hip_atomic_load(p, __ATOMIC_RELAXED, __HIP_MEMORY_SCOPE_AGENT); }
__device__ __forceinline__ unsigned xb_add(unsigned* p, unsigned v) { return __hip_atomic_fetch_add(p, v, __ATOMIC_RELAXED, __HIP_MEMORY_SCOPE_AGENT); }
__device__ __forceinline__ unsigned xb_xcc_id() { return (unsigned)__builtin_amdgcn_s_getreg((3 << 11) | 20) & 0xFu; }
#define XB_SPIN(cond, bar) do { unsigned _sp = 0; while (cond) { __builtin_amdgcn_s_sleep(1); \
    if ((++_sp & 255u) == 0u) { if (xb_ld(&(bar)[XB_TMO])) break; if (_sp > XB_SPIN_CAP) { atomicAdd(&(bar)[XB_TMO], 1u); break; } } } } while (0)

struct XcdBarrier {
    unsigned* bar; unsigned x;
    volatile LAS unsigned* st;
};

__device__ __forceinline__ XcdBarrier xcd_barrier_post(unsigned* bar, volatile LAS unsigned* st) {
    XcdBarrier b; b.bar = bar; b.x = xb_xcc_id(); b.st = st;
    if (threadIdx.x == 0) (void)xb_add(&bar[XB_XCNT(b.x)], 1u);
    return b;
}
__device__ __forceinline__ void xcd_barrier_complete(unsigned* bar, unsigned x, unsigned& nloc, unsigned& nx) {
    const unsigned G = gridDim.x * gridDim.y * gridDim.z;
    unsigned sum, cnt, mine, sp = 0u;
    for (;;) {
        sum = 0u; cnt = 0u; mine = 0u;
#pragma unroll
        for (unsigned j = 0; j < 16; ++j) { const unsigned c = xb_ld(&bar[XB_XCNT(j)]); sum += c; cnt += (c > 0u) ? 1u : 0u; mine = (j == x) ? c : mine; }
        if (sum == G) break;
        __builtin_amdgcn_s_sleep(1);
        if ((++sp & 255u) == 0u) { if (xb_ld(&bar[XB_TMO])) break; if (sp > XB_SPIN_CAP) { atomicAdd(&bar[XB_TMO], 1u); break; } }
    }
    nloc = mine > 0u ? mine : 1u; nx = cnt > 0u ? cnt : 1u;
}

__device__ __forceinline__ void xcd_barrier(const XcdBarrier& b) {
    asm volatile("s_waitcnt vmcnt(0)" ::: "memory");
    __syncthreads();
    if (threadIdx.x == 0) {
        unsigned* bar = b.bar;
        __builtin_amdgcn_s_waitcnt(0);
        unsigned nloc = b.st[0], nx = b.st[1];
        if (nloc == 0u) { xcd_barrier_complete(bar, b.x, nloc, nx); b.st[0] = nloc; b.st[1] = nx; }
        const unsigned old = xb_add(&bar[XB_XSUB(b.x)], 1u);
        const unsigned gen = old / nloc;
        if (old + 1u == (gen + 1u) * nloc) {
            __builtin_amdgcn_fence(__ATOMIC_RELEASE, "agent");
            asm volatile("s_waitcnt vmcnt(0)" ::: "memory");
            const unsigned og = xb_add(&bar[XB_TOP], 1u);
            const unsigned tg = og / nx;
            if (og + 1u == (tg + 1u) * nx) xb_add(&bar[XB_TOPGEN], 1u);
            else XB_SPIN(xb_ld(&bar[XB_TOPGEN]) == tg, bar);
            __builtin_amdgcn_fence(__ATOMIC_ACQUIRE, "agent");
            xb_add(&bar[XB_XGEN(b.x)], 1u);
            asm volatile("s_waitcnt vmcnt(0)" ::: "memory");
        } else {
            XB_SPIN(xb_ld(&bar[XB_XGEN(b.x)]) == gen, bar);
            __builtin_amdgcn_fence(__ATOMIC_ACQUIRE, "agent");
            asm volatile("s_waitcnt vmcnt(0)" ::: "memory");
        }
    }
    __syncthreads();
}

#define GEMMX(ABLKv, EpiT, Eobj, Aptr, Btptr, Nn, Kk) do { pg8::Gemm g_{(const pg8::bf16_t*)(Aptr), (const pg8::bf16_t*)(Btptr), M, (Nn), (Kk)}; pg8::StaticOrder S_; S_.init(M, (Nn), (int)gridDim.x, (int)blockIdx.x); \
    pg8::gemm_phase<EpiT, pg8::StaticOrder, true, true, ABLKv>((PG8_LAS unsigned char*)lds, g_, S_, Eobj); } while (0)
#define GEMM(EpiT, Eobj, Aptr, Btptr, Nn, Kk) GEMMX(false, EpiT, Eobj, Aptr, Btptr, Nn, Kk)

__global__ void __launch_bounds__(512, 2) fwd_megakernel(Ctx C) {
    extern __shared__ __attribute__((aligned(16))) unsigned char lds_raw[];
    LAS unsigned char* lds = (LAS unsigned char*)lds_raw;
    cg::grid_group grid = cg::this_grid();
    const int tid = threadIdx.x, wave = __builtin_amdgcn_readfirstlane(tid >> 6), lane = tid & 63;
    unsigned char* ws = C.ws;
    float* stat = (float*)(ws + WS_STAT); float* rowss1 = stat; float* rowss2 = stat + M; float* vsum = stat + 2 * M; float* vsumsq = stat + 3 * M;
    const float* tcos = (const float*)(ws + WS_TAB); const float* tsin = tcos + SEQ * 128;
    bf16* XB = (bf16*)(ws + WS_XB); bf16* ACT = (bf16*)(ws + WS_ACT);

    volatile LAS unsigned* bst = (volatile LAS unsigned*)(lds + LDS_BYTES - 16);
    if (tid == 0) { bst[0] = 0u; bst[1] = 0u; }
    __syncthreads();
    (void)xcd_barrier_post((unsigned*)(ws + WS_BAR), bst);
    if (C.ws == nullptr) grid.sync();
#define GBAR() do { XcdBarrier xb_; xb_.bar = (unsigned*)(C.ws + WS_BAR); xb_.x = xb_xcc_id(); xb_.st = (volatile LAS unsigned*)(lds + LDS_BYTES - 16); xcd_barrier(xb_); } while (0)
    p0_prologue(C, lds, tid, wave, lane);
    GBAR();
    { EpiSwiGLU E{ACT, nullptr, 0.f, 0.f, 0.f, 0.f, 0.f, 0.f, 0.f, 0.f, -1}; GEMM(EpiSwiGLU, E, XB, ws + WS_WGU, 2 * FF, D); }
    {
        const int G = (int)gridDim.x, tail = (64 * 22) % G; int cb = -1, ncb = 1;
        if (tail == 0) { cb = (int)blockIdx.x; ncb = G; } else if ((int)blockIdx.x >= tail) { cb = (int)blockIdx.x - tail; ncb = G - tail; }
        if (cb >= 0) convert_rest(C, lds, cb, ncb, tid, wave, lane);
    }
    GBAR();
    { EpiResid E{(const bf16*)(ws + WS_S3), nullptr, XB, rowss1, 0.5f}; GEMMX(true, EpiResid, E, ACT, ws + WS_WD, D, FF); }
    GBAR();
    { EpiInProj E{rowss1, C.in[7], ws, vsum, vsumsq, tcos, tsin, 0, (bf16*)C.out, 0.f, 0.f, 0.f, 0.f, 0.f, 0.f, 0.f, 0.f, -1}; GEMM(EpiInProj, E, XB, ws + WS_WIN, 3 * D, D); }
    GBAR();
    sgu_phase(C, lds, tid, wave, lane);
    GBAR();
    { EpiBranch E{(const bf16*)(ws + WS_S2), nullptr, (bf16*)(ws + WS_S2)}; GEMM(EpiBranch, E, ws + WS_S0, ws + WS_WA, D, D); }
    { EpiInProj E{rowss1, C.in[7], ws, vsum, vsumsq, tcos, tsin, 12, (bf16*)C.out, 0.f, 0.f, 0.f, 0.f, 0.f, 0.f, 0.f, 0.f, -1}; GEMM(EpiInProj, E, XB, ws + WS_WIN + (size_t)3 * D * D * 2, 5 * D, D); }
    GBAR();
    r1_phase(C, lds, tid, wave, lane);
    GBAR();
    r2_phase(C, tid);
    GBAR();
    r3_phase(C, lds, tid, wave, lane);
    GBAR();
    { EpiBranch E{(const bf16*)(ws + WS_S5), (const bf16*)(ws + WS_S2), (bf16*)(ws + WS_S2)}; GEMM(EpiBranch, E, C.out, ws + WS_WB, D, D); }
    GBAR();
    { EpiResid E{XB, nullptr, XB, rowss2, 1.0f}; GEMM(EpiResid, E, ws + WS_S2, ws + WS_WO, D, D); }
    GBAR();
    { EpiSwiGLU E{ACT, rowss2, 0.f, 0.f, 0.f, 0.f, 0.f, 0.f, 0.f, 0.f, -1}; GEMM(EpiSwiGLU, E, XB, (unsigned char*)C.out + OUT_WGU2, 2 * FF, D); }
    GBAR();
    { EpiFinal E{XB, stat + 4 * M, (unsigned*)(ws + WS_CNT), C.in[20], C.out}; GEMMX(true, EpiFinal, E, ACT, ws + WS_WD2, D, FF); }
}

extern "C" void kernel_launch(void* const* d_in, const int* in_sizes, int n_in, void* d_out, int out_size, void* d_ws, size_t ws_size, hipStream_t stream) {
    static int grid = 0;
    if (grid == 0) {
        if (n_in != 21 || out_size != M * D || ws_size < 256 * MiB) { fprintf(stderr, "kernel_launch: unexpected shapes (n_in %d out %d ws %zu)\n", n_in, out_size, ws_size); grid = -1; return; }
        int dev = 0, cus = 0, per_cu = 0;
        hipGetDevice(&dev); hipDeviceGetAttribute(&cus, hipDeviceAttributeMultiprocessorCount, dev);
        if (hipFuncSetAttribute((const void*)fwd_megakernel, hipFuncAttributeMaxDynamicSharedMemorySize, LDS_BYTES) != hipSuccess) { fprintf(stderr, "kernel_launch: hipFuncSetAttribute failed\n"); grid = -1; return; }
        if (hipOccupancyMaxActiveBlocksPerMultiprocessor(&per_cu, (const void*)fwd_megakernel, 512, LDS_BYTES) != hipSuccess || per_cu < 1) { fprintf(stderr, "kernel_launch: occupancy query says %d blocks per CU\n", per_cu); per_cu = 1; }
        (void)hipGetLastError();
        grid = cus * 1;
    }
    if (grid < 0) return;
    if (hipMemsetAsync((char*)d_ws + WS_BAR, 0, XCD_BAR_WORDS * sizeof(unsigned), stream) != hipSuccess) { fprintf(stderr, "kernel_launch: hipMemsetAsync failed\n"); return; }
    Ctx c{};
    for (int i = 0; i < 21; ++i) c.in[i] = (const float*)d_in[i];
    c.out = (float*)d_out; c.ws = (unsigned char*)d_ws;
    void* args[] = {&c};
    hipError_t e = hipLaunchCooperativeKernel((const void*)fwd_megakernel, dim3(grid), dim3(512), args, LDS_BYTES, stream);
    if (e != hipSuccess) fprintf(stderr, "cooperative launch failed: %s (grid %d)\n", hipGetErrorString(e), grid);
}
```

```cpp
#include <hip/hip_runtime.h>
#include <hip/hip_cooperative_groups.h>
#include <cstdio>
#include <cstdint>
namespace cg = cooperative_groups;
namespace pg8 {
#define PG8_LAS __attribute__((address_space(3)))
typedef unsigned short bf16_t;
typedef short bf16x8 __attribute__((ext_vector_type(8)));
typedef float f32x4 __attribute__((ext_vector_type(4)));
typedef unsigned u32x4 __attribute__((ext_vector_type(4)));
constexpr int BM = 256, BK = 64, HALF = 128, HTB = HALF * BK * 2  , STAGE_BYTES = 8 * HTB, NXCD = 8, WGM = 4;

__host__ __device__ __forceinline__ int lds_byte(int r, int c) { const int st = (r >> 4) * 2 + (c >> 5), rr = r & 15, cc = c & 31, ob = rr * 64 + cc * 2; return st * 1024 + (ob ^ (((ob >> 9) & 1) << 5)); }
__host__ __device__ __forceinline__ void stage_rc(int b, int& R, int& C) { const int st = b / 1024, sb = b % 1024, swz = sb ^ (((sb >> 9) & 1) << 5); R = (st >> 1) * 16 + swz / 64; C = (st & 1) * 32 + (swz % 64) / 2; }
__host__ __device__ __forceinline__ int perm32(int rho) { const int n = rho >> 4, i = rho & 15; return 8 * (i >> 2) + 4 * n + (i & 3); }

struct Unit { int pm, pn; };
struct Gemm { const bf16_t* A; const bf16_t* Bt; int M, N, K; };

struct StaticOrder {
    int nM, nN, nwg, G, c;
    __host__ __device__ void init(int M, int N, int G_, int c_) { nM = M / BM; nN = N / BM; nwg = nM * nN; G = G_; c = c_; }
    __host__ __device__ bool next(int i, Unit& u) const {
        const long L = (long)i * G + c; if (L >= nwg) return false;
        int wgid = (int)L; { const int q = nwg / NXCD, r = nwg % NXCD, xcd = wgid % NXCD, off = wgid / NXCD; wgid = (xcd < r ? xcd * (q + 1) : r * (q + 1) + (xcd - r) * q) + off; }
        const int nig = WGM * nN, gid = wgid / nig, fm = gid * WGM, gsz = (nM - fm) < WGM ? (nM - fm) : WGM;
        u.pm = fm + ((wgid % nig) % gsz); u.pn = (wgid % nig) / gsz; return true;
    }
    __device__ __forceinline__ void a_ready(const Unit&) const {}
    __device__ __forceinline__ void done(const Unit&) const {}
};
__device__ __forceinline__ unsigned cvt_pk_bf16(float lo, float hi) { unsigned r; asm volatile("v_cvt_pk_bf16_f32 %0, %1, %2" : "=v"(r) : "v"(lo), "v"(hi)); return r; }
typedef float f32x2 __attribute__((ext_vector_type(2)));
__device__ __forceinline__ f32x2 gelu_pk(f32x2 v) {
    const f32x2 av = __builtin_elementwise_abs(v), d = av * 0.2316418882f + 1.0f;
    f32x2 t; t.x = __builtin_amdgcn_rcpf(d.x); t.y = __builtin_amdgcn_rcpf(d.y);
    f32x2 q = t * 0.5307027145f + (-0.7265760135f); q = q * t + 0.7107068705f; q = q * t + (-0.142248368f); q = q * t + 0.127414796f; q = q * t;
    const f32x2 s = (v * v) * (-0.72134752044f);
    f32x2 e; e.x = __builtin_amdgcn_exp2f(s.x); e.y = __builtin_amdgcn_exp2f(s.y);
    const f32x2 m = v * (q * e), r = v - m;
    f32x2 o; o.x = v.x < 0.f ? m.x : r.x; o.y = v.y < 0.f ? m.y : r.y; return o;
}
template <class Epi, class Sched, bool ALIGN_EPI = false, bool SP2 = false, bool ABLK = false>
__device__ __forceinline__ void gemm_phase(PG8_LAS unsigned char* lds, const Gemm g, const Sched& S, const Epi& E) {
    int tid_ = threadIdx.x; asm volatile("" : "+v"(tid_));
    const int tid = tid_, wid = __builtin_amdgcn_readfirstlane(tid >> 6), lane = tid & 63, wr = wid >> 2, wc = wid & 3, fr = lane & 15, fq = lane >> 4;
    const int K = g.K, nt = K / BK;
    unsigned voffA[2], voffB[2];
#pragma unroll
    for (int i = 0; i < 2; ++i) { int R, C; stage_rc(tid * 16 + i * 8192, R, C); const int Rb = Epi::PERM ? ((R & ~31) + perm32(R & 31)) : R;
        voffA[i] = ABLK ? (unsigned)(R * BK + C) * 2u : (unsigned)(R * K + C) * 2u; voffB[i] = (unsigned)(Rb * K + C) * 2u; }
    const size_t kstep = (size_t)(BK * 2);
    const size_t hstep = (size_t)HALF * K * 2;
    const size_t tstep = 2 * hstep;
    const size_t kstepA = ABLK ? (size_t)(BM * BK * 2) : kstep, hstepA = ABLK ? (size_t)(HALF * BK * 2) : hstep, tstepA = ABLK ? (size_t)(K / BK) * (size_t)(BM * BK * 2) : tstep;
    const unsigned ldsw = (unsigned)wid * 1024u;
    const int aoff = lds_byte(wr * 64 + fr, fq * 8), boff = lds_byte(wc * 32 + fr, fq * 8);
#define PG8_SA(b, h) (((b) * 2 + (h)) * HTB)
#define PG8_SB(b, h) ((4 + (b) * 2 + (h)) * HTB)
#define PG8_STAGE(bufoff, gbase, voff) do { _Pragma("unroll") for (int _i = 0; _i < 2; ++_i) \
        __builtin_amdgcn_global_load_lds((const unsigned*)((const char*)(gbase) + (voff)[_i]), (PG8_LAS unsigned*)(lds + (bufoff) + ldsw + _i * 8192), 16, 0, 0); } while (0)
#define PG8_LDA(dst, b, h) do { _Pragma("unroll") for (int m = 0; m < 4; ++m) _Pragma("unroll") for (int k = 0; k < 2; ++k) dst[m][k] = *(const PG8_LAS bf16x8*)(lds + PG8_SA(b, h) + aoff + m * 2048 + k * 1024); } while (0)
#define PG8_LDB(dst, b, h) do { _Pragma("unroll") for (int n = 0; n < 2; ++n) _Pragma("unroll") for (int k = 0; k < 2; ++k) dst[n][k] = *(const PG8_LAS bf16x8*)(lds + PG8_SB(b, h) + boff + n * 2048 + k * 1024); } while (0)
#define PG8_MMA(ai, bj, At, Bt) do { __builtin_amdgcn_s_setprio(1); _Pragma("unroll") for (int m = 0; m < 4; ++m) _Pragma("unroll") for (int n = 0; n < 2; ++n) _Pragma("unroll") for (int k = 0; k < 2; ++k) \
        acc[ai][bj][m][n] = __builtin_amdgcn_mfma_f32_16x16x32_bf16(Bt[n][k], At[m][k], acc[ai][bj][m][n], 0, 0, 0); __builtin_amdgcn_s_setprio(0); } while (0)
#define PG8_WAIT_V(n) asm volatile("s_waitcnt vmcnt(" #n ")" ::: "memory")
#define PG8_WAIT_L(n) asm volatile("s_waitcnt lgkmcnt(" #n ")" ::: "memory")
#define PG8_BAR __builtin_amdgcn_s_barrier()
#define PG8_SCHED __builtin_amdgcn_sched_barrier(0)
    Unit cur, nxt; int ui = 0;
    if (!S.next(0, cur)) return;
    f32x4 acc[2][2][4][2];
    if constexpr (Epi::ACC_INIT) E.init(acc, cur, wr, wc, fr, fq);
    else {
#pragma unroll
    for (int a = 0; a < 2; ++a)
#pragma unroll
        for (int b = 0; b < 2; ++b)
#pragma unroll
            for (int m = 0; m < 4; ++m)
#pragma unroll
                for (int n = 0; n < 2; ++n) acc[a][b][m][n] = (f32x4){0.f, 0.f, 0.f, 0.f};
    }
    bf16x8 At[4][2], B0[2][2], B1[2][2];
    const char* cA = (const char*)g.A + (size_t)cur.pm * tstepA; const char* cB = (const char*)g.Bt + (size_t)cur.pn * tstep;
    S.a_ready(cur);
    if constexpr (SP2) {
        PG8_STAGE(PG8_SB(0, 0), cB, voffB); PG8_STAGE(PG8_SB(0, 1), cB + hstep, voffB); PG8_STAGE(PG8_SA(0, 0), cA, voffA); PG8_STAGE(PG8_SA(0, 1), cA + hstepA, voffA);
        if (wr == 1) PG8_BAR;
        PG8_WAIT_V(2); PG8_BAR;
        PG8_STAGE(PG8_SB(1, 0), cB + kstep, voffB); PG8_STAGE(PG8_SA(1, 0), cA + kstepA, voffA); PG8_STAGE(PG8_SB(1, 1), cB + hstep + kstep, voffB);
        PG8_WAIT_V(6); PG8_BAR;
    } else {
        PG8_STAGE(PG8_SB(0, 0), cB, voffB); PG8_STAGE(PG8_SA(0, 0), cA, voffA); PG8_STAGE(PG8_SB(0, 1), cB + hstep, voffB); PG8_STAGE(PG8_SA(0, 1), cA + hstepA, voffA);
        if (wr == 1) PG8_BAR;
        PG8_WAIT_V(4); PG8_BAR;
        PG8_STAGE(PG8_SB(1, 0), cB + kstep, voffB); PG8_STAGE(PG8_SA(1, 0), cA + kstepA, voffA); PG8_STAGE(PG8_SB(1, 1), cB + hstep + kstep, voffB);
        PG8_WAIT_V(6); PG8_BAR;
    }
    for (;;) {
        const bool has_next = S.next(ui + 1, nxt);
        const char* nA = has_next ? (const char*)g.A + (size_t)nxt.pm * tstepA : cA; const char* nB = has_next ? (const char*)g.Bt + (size_t)nxt.pn * tstep : cB;
        for (int t = 0; t < nt; t += 2) {
            const bool last = (t == nt - 2);
            const char* a1 = cA + (size_t)(t + 1) * kstepA;
            const char* a2 = last ? nA : cA + (size_t)(t + 2) * kstepA; const char* b2 = last ? nB : cB + (size_t)(t + 2) * kstep;
            const char* a3 = a2 + kstepA; const char* b3 = b2 + kstep;
            if (last && has_next) S.a_ready(nxt);
            if constexpr (SP2) {
            PG8_LDB(B0, 0, 0); PG8_LDB(B1, 0, 1); PG8_SCHED; PG8_LDA(At, 0, 0); PG8_STAGE(PG8_SA(1, 1), a1 + hstepA, voffA);
            PG8_WAIT_V(8); PG8_WAIT_L(0); PG8_BAR; PG8_MMA(0, 0, At, B0); PG8_MMA(0, 1, At, B1); PG8_BAR; PG8_SCHED;
            PG8_LDA(At, 0, 1); PG8_STAGE(PG8_SB(0, 0), b2, voffB); PG8_STAGE(PG8_SB(0, 1), b2 + hstep, voffB); PG8_STAGE(PG8_SA(0, 0), a2, voffA);
            PG8_WAIT_V(8); PG8_WAIT_L(0); PG8_BAR; PG8_MMA(1, 0, At, B0); PG8_MMA(1, 1, At, B1); PG8_BAR; PG8_SCHED;
            PG8_LDB(B0, 1, 0); PG8_LDB(B1, 1, 1); PG8_SCHED; PG8_LDA(At, 1, 0); PG8_STAGE(PG8_SA(0, 1), a2 + hstepA, voffA);
            PG8_WAIT_V(8); PG8_WAIT_L(0); PG8_BAR; PG8_MMA(0, 0, At, B0); PG8_MMA(0, 1, At, B1); PG8_BAR; PG8_SCHED;
            PG8_LDA(At, 1, 1); PG8_STAGE(PG8_SB(1, 0), b3, voffB); PG8_STAGE(PG8_SB(1, 1), b3 + hstep, voffB); PG8_STAGE(PG8_SA(1, 0), a3, voffA);
            PG8_WAIT_V(8); PG8_WAIT_L(0); PG8_BAR; PG8_MMA(1, 0, At, B0); PG8_MMA(1, 1, At, B1); PG8_BAR; PG8_SCHED;
            } else {
            PG8_LDB(B0, 0, 0); PG8_SCHED; PG8_LDA(At, 0, 0); PG8_STAGE(PG8_SA(1, 1), a1 + hstepA, voffA);
            PG8_WAIT_L(8); PG8_BAR; PG8_WAIT_L(0); PG8_MMA(0, 0, At, B0); PG8_BAR; PG8_SCHED;
            PG8_LDB(B1, 0, 1); PG8_STAGE(PG8_SB(0, 0), b2, voffB);
            PG8_BAR; PG8_WAIT_L(0); PG8_MMA(0, 1, At, B1); PG8_BAR;
            PG8_LDA(At, 0, 1); PG8_STAGE(PG8_SA(0, 0), a2, voffA);
            PG8_BAR; PG8_WAIT_L(0); PG8_MMA(1, 0, At, B0); PG8_BAR; PG8_SCHED;
            PG8_STAGE(PG8_SB(0, 1), b2 + hstep, voffB);
            PG8_WAIT_V(6); PG8_BAR; PG8_MMA(1, 1, At, B1); PG8_BAR;
            PG8_LDB(B0, 1, 0); PG8_SCHED; PG8_LDA(At, 1, 0); PG8_STAGE(PG8_SA(0, 1), a2 + hstepA, voffA);
            PG8_WAIT_L(8); PG8_BAR; PG8_WAIT_L(0); PG8_MMA(0, 0, At, B0); PG8_BAR; PG8_SCHED;
            PG8_LDB(B1, 1, 1); PG8_STAGE(PG8_SB(1, 0), b3, voffB);
            PG8_BAR; PG8_WAIT_L(0); PG8_MMA(0, 1, At, B1); PG8_BAR;
            PG8_LDA(At, 1, 1); PG8_STAGE(PG8_SA(1, 0), a3, voffA);
            PG8_BAR; PG8_WAIT_L(0); PG8_MMA(1, 0, At, B0); PG8_BAR; PG8_SCHED;
            PG8_STAGE(PG8_SB(1, 1), b3 + hstep, voffB);
            PG8_WAIT_V(6); PG8_BAR; PG8_MMA(1, 1, At, B1); PG8_BAR;
            }
        }
        if constexpr (ALIGN_EPI) { if (wr == 0) PG8_BAR; }
        if constexpr (!Epi::AFTER_DRAIN) { E(acc, cur, wr, wc, fr, fq); S.done(cur); }
        if (!has_next) break;
        if constexpr (Epi::ACC_INIT) E.init(acc, nxt, wr, wc, fr, fq);
        else {
#pragma unroll
        for (int a = 0; a < 2; ++a)
#pragma unroll
            for (int b = 0; b < 2; ++b)
#pragma unroll
                for (int m = 0; m < 4; ++m)
#pragma unroll
                    for (int n = 0; n < 2; ++n) acc[a][b][m][n] = (f32x4){0.f, 0.f, 0.f, 0.f};
        }
        cur = nxt; cA = nA; cB = nB; ++ui;
        if constexpr (ALIGN_EPI) { if (wr == 1) PG8_BAR; }
    }
    PG8_WAIT_V(0);
    if constexpr (!ALIGN_EPI) { if (wr == 0) PG8_BAR; }
    PG8_BAR;
    if constexpr (Epi::AFTER_DRAIN) { E.fused(acc, cur, wr, wc, fr, fq, lds, wid, lane); S.done(cur); }
#undef PG8_SA
#undef PG8_SB
#undef PG8_STAGE
#undef PG8_LDA
#undef PG8_LDB
#undef PG8_MMA
#undef PG8_WAIT_V
#undef PG8_WAIT_L
#undef PG8_BAR
#undef PG8_SCHED
}
}

#define LAS __attribute__((address_space(3)))
typedef unsigned short bf16;
typedef unsigned v4u __attribute__((ext_vector_type(4)));
typedef unsigned v2u __attribute__((ext_vector_type(2)));
typedef float f32x4 __attribute__((ext_vector_type(4)));
typedef float f32x2 __attribute__((ext_vector_type(2)));
typedef short bf16x8 __attribute__((ext_vector_type(8)));
typedef short s16x4 __attribute__((ext_vector_type(4)));
using pg8::cvt_pk_bf16;

constexpr int M = 16384, D = 1024, FF = 2816, SEQ = 4096, NH = 4;
constexpr float EPS = 1e-6f;
constexpr size_t MiB = 1u << 20;
constexpr size_t WS_STAT = 0;
constexpr size_t WS_CNT = 320 * 1024;
static_assert(WS_CNT == (size_t)5 * 16384 * 4, "counters directly above the statistics");
constexpr size_t WS_BAR = 400 * 1024;
constexpr size_t HMiB = 512 * 1024;
constexpr size_t WS_TAB = 1 * HMiB;
constexpr size_t WS_WA = 9 * HMiB, WS_WB = 13 * HMiB, WS_WO = 17 * HMiB;
constexpr size_t WS_WIN = 21 * HMiB;
constexpr size_t WS_XB = 53 * HMiB;
constexpr size_t WS_G = 117 * HMiB;
constexpr size_t SLOT = 32 * MiB;
constexpr size_t WS_S0 = WS_G, WS_S1 = WS_G + SLOT, WS_S2 = WS_G + 2 * SLOT, WS_S3 = WS_G + 3 * SLOT, WS_S4 = WS_G + 4 * SLOT, WS_S5 = WS_G + 5 * SLOT;
constexpr size_t WS_ACT = WS_G;
constexpr size_t WS_WGU = 437 * HMiB;
constexpr size_t WS_WD = 459 * HMiB;
constexpr size_t WS_WD2 = 501 * HMiB;
static_assert(WS_S5 + SLOT <= WS_WD2 && WS_WD2 + (size_t)D * FF * 2 <= 256 * MiB && WS_WD + (size_t)D * FF * 2 <= WS_S5 + SLOT && WS_ACT + (size_t)M * FF * 2 <= WS_WGU && WS_WGU >= WS_S5, "ws map");
constexpr int LDS_BYTES = 147456;

__device__ __forceinline__ float bflo(unsigned w) { return __uint_as_float(w << 16); }
__device__ __forceinline__ float bfhi(unsigned w) { return __uint_as_float(w & 0xffff0000u); }
__device__ __forceinline__ float sigmoidf_(float x) { return __builtin_amdgcn_rcpf(1.f + __builtin_amdgcn_exp2f(-1.44269504f * x)); }
__device__ __forceinline__ float siluf_(float x) { return x * sigmoidf_(x); }
#define LDS_WAIT() asm volatile("s_waitcnt lgkmcnt(0)" ::: "memory")

struct EpiSwiGLU {
    static constexpr bool PERM = true, AFTER_DRAIN = false, ACC_INIT = false;
    bf16* O; const float* rowss;
    __device__ __forceinline__ void operator()(const f32x4 (&acc)[2][2][4][2], const pg8::Unit& u, int wr, int wc, int fr, int fq) const {
        const int row0 = u.pm * 256 + wr * 64 + fr, col0 = u.pn * 128 + wc * 32 + 8 * fq;
        float rsv[2][4];
#pragma unroll
        for (int ai = 0; ai < 2; ++ai)
#pragma unroll
            for (int m = 0; m < 4; ++m) rsv[ai][m] = rowss ? rowss[row0 + ai * 128 + m * 16] : 0.f;
#pragma unroll
        for (int ai = 0; ai < 2; ++ai)
#pragma unroll
            for (int m = 0; m < 4; ++m) {
                const int row = row0 + ai * 128 + m * 16;
                const float rs = rowss ? __builtin_amdgcn_rsqf(rsv[ai][m] * (1.f / 1024.f) + EPS) : 1.f;
                float o[8];
#pragma unroll
                for (int n = 0; n < 2; ++n)
#pragma unroll
                    for (int j = 0; j < 4; ++j) { const float g = acc[ai][0][m][n][j] * rs, up = acc[ai][1][m][n][j] * rs; o[n * 4 + j] = siluf_(g) * up; }
                v4u w; w.x = cvt_pk_bf16(o[0], o[1]); w.y = cvt_pk_bf16(o[2], o[3]); w.z = cvt_pk_bf16(o[4], o[5]); w.w = cvt_pk_bf16(o[6], o[7]);
                *(v4u*)(O + ((size_t)((row >> 8) * (FF / 64) + (col0 >> 6)) * 256 + (row & 255)) * 64 + (col0 & 63)) = w;
            }
    }
};
struct EpiResid {
    static constexpr bool PERM = true, AFTER_DRAIN = false, ACC_INIT = true;
    const bf16* resb; float* out; bf16* xb; float* rowss; float scale;
    __device__ __forceinline__ void init(f32x4 (&acc)[2][2][4][2], const pg8::Unit& u, int wr, int wc, int fr, int fq) const {
        const int row0 = u.pm * 256 + wr * 64 + fr, col0 = u.pn * 256 + wc * 32 + 8 * fq; const float is = 1.f / scale;
#pragma unroll
        for (int ai = 0; ai < 2; ++ai)
#pragma unroll
            for (int m = 0; m < 4; ++m)
#pragma unroll
                for (int bj = 0; bj < 2; ++bj) {
                    const v4u rb = *(const v4u*)(resb + (size_t)(row0 + ai * 128 + m * 16) * D + col0 + bj * 128);
                    acc[ai][bj][m][0] = (f32x4){bflo(rb.x) * is, bfhi(rb.x) * is, bflo(rb.y) * is, bfhi(rb.y) * is};
                    acc[ai][bj][m][1] = (f32x4){bflo(rb.z) * is, bfhi(rb.z) * is, bflo(rb.w) * is, bfhi(rb.w) * is};
                }
    }
    __device__ __forceinline__ void operator()(const f32x4 (&acc)[2][2][4][2], const pg8::Unit& u, int wr, int wc, int fr, int fq) const {
        const int row0 = u.pm * 256 + wr * 64 + fr, col0 = u.pn * 256 + wc * 32 + 8 * fq;
#pragma unroll
        for (int ai = 0; ai < 2; ++ai)
#pragma unroll
            for (int m = 0; m < 4; ++m) {
                const int row = row0 + ai * 128 + m * 16; float ss = 0.f;
#pragma unroll
                for (int bj = 0; bj < 2; ++bj) {
                    const size_t off = (size_t)row * D + col0 + bj * 128;
                    const f32x4 o0 = acc[ai][bj][m][0] * scale, o1 = acc[ai][bj][m][1] * scale;
                    if (out) { *(f32x4*)(out + off) = o0; *(f32x4*)(out + off + 4) = o1; }
                    ss += (o0[0] * o0[0] + o0[1] * o0[1]) + (o0[2] * o0[2] + o0[3] * o0[3]) + (o1[0] * o1[0] + o1[1] * o1[1]) + (o1[2] * o1[2] + o1[3] * o1[3]);
                    if (xb) { v4u w; w.x = cvt_pk_bf16(o0[0], o0[1]); w.y = cvt_pk_bf16(o0[2], o0[3]); w.z = cvt_pk_bf16(o1[0], o1[1]); w.w = cvt_pk_bf16(o1[2], o1[3]); *(v4u*)(xb + off) = w; }
                }
                if (rowss) { ss += __shfl_xor(ss, 16); ss += __shfl_xor(ss, 32); if (fq == 0) atomicAdd(rowss + row, ss); }
            }
    }
};
struct EpiFinal {
    static constexpr bool PERM = true, AFTER_DRAIN = false, ACC_INIT = true;
    const bf16* resb; float* rowss; unsigned* cnt; const float* gn; float* out;
    __device__ __forceinline__ void init(f32x4 (&acc)[2][2][4][2], const pg8::Unit& u, int wr, int wc, int fr, int fq) const {
        const int row0 = u.pm * 256 + wr * 64 + fr, col0 = u.pn * 256 + wc * 32 + 8 * fq;
#pragma unroll
        for (int ai = 0; ai < 2; ++ai)
#pragma unroll
            for (int m = 0; m < 4; ++m)
#pragma unroll
                for (int bj = 0; bj < 2; ++bj) {
                    const v4u rb = *(const v4u*)(resb + (size_t)(row0 + ai * 128 + m * 16) * D + col0 + bj * 128);
                    acc[ai][bj][m][0] = (f32x4){bflo(rb.x) * 2.f, bfhi(rb.x) * 2.f, bflo(rb.y) * 2.f, bfhi(rb.y) * 2.f};
                    acc[ai][bj][m][1] = (f32x4){bflo(rb.z) * 2.f, bfhi(rb.z) * 2.f, bflo(rb.w) * 2.f, bfhi(rb.w) * 2.f};
                }
    }
    __device__ __forceinline__ void operator()(const f32x4 (&acc)[2][2][4][2], const pg8::Unit& u, int wr, int wc, int fr, int fq) const {
        const int row0 = u.pm * 256 + wr * 64 + fr, col0 = u.pn * 256 + wc * 32 + 8 * fq;
#pragma unroll
        for (int ai = 0; ai < 2; ++ai)
#pragma unroll
            for (int m = 0; m < 4; ++m) {
                float ss = 0.f;
#pragma unroll
                for (int bj = 0; bj < 2; ++bj) { const f32x4 c0 = acc[ai][bj][m][0], c1 = acc[ai][bj][m][1];
                    ss += (c0[0] * c0[0] + c0[1] * c0[1]) + (c0[2] * c0[2] + c0[3] * c0[3]) + (c1[0] * c1[0] + c1[1] * c1[1]) + (c1[2] * c1[2] + c1[3] * c1[3]); }
                ss *= 0.25f;
                ss += __shfl_xor(ss, 16); ss += __shfl_xor(ss, 32);
                if (fq == 0) atomicAdd(rowss + row0 + ai * 128 + m * 16, ss);
            }
        asm volatile("s_waitcnt vmcnt(0)" ::: "memory");
        unsigned* c = cnt + 64 * u.pm;
        if ((threadIdx.x & 63) == 0) __hip_atomic_fetch_add(c, 1u, __ATOMIC_RELAXED, __HIP_MEMORY_SCOPE_AGENT);
        { unsigned spins = 0; while (__hip_atomic_load(c, __ATOMIC_RELAXED, __HIP_MEMORY_SCOPE_AGENT) < 32u && ++spins < (1u << 22)) __builtin_amdgcn_s_sleep(2); }
        asm volatile("" ::: "memory");
        float rsv[2][4];
#pragma unroll
        for (int ai = 0; ai < 2; ++ai)
#pragma unroll
            for (int m = 0; m < 4; ++m) rsv[ai][m] = 0.5f * __builtin_amdgcn_rsqf(__hip_atomic_load(rowss + row0 + ai * 128 + m * 16, __ATOMIC_RELAXED, __HIP_MEMORY_SCOPE_AGENT) * (1.f / D) + EPS);
        f32x4 g0[2], g1[2];
#pragma unroll
        for (int bj = 0; bj < 2; ++bj) { g0[bj] = *(const f32x4*)(gn + col0 + bj * 128); g1[bj] = *(const f32x4*)(gn + col0 + bj * 128 + 4); }
#pragma unroll
        for (int ai = 0; ai < 2; ++ai)
#pragma unroll
            for (int m = 0; m < 4; ++m) {
                const float rs = rsv[ai][m];
#pragma unroll
                for (int bj = 0; bj < 2; ++bj) {
                    const size_t off = (size_t)(row0 + ai * 128 + m * 16) * D + col0 + bj * 128;
                    *(f32x4*)(out + off) = acc[ai][bj][m][0] * rs * g0[bj];
                    *(f32x4*)(out + off + 4) = acc[ai][bj][m][1] * rs * g1[bj];
                }
            }
    }
};
struct EpiBranch {
    static constexpr bool PERM = true, AFTER_DRAIN = false, ACC_INIT = false;
    const bf16* gate; const bf16* add; bf16* out;
    __device__ __forceinline__ void operator()(const f32x4 (&acc)[2][2][4][2], const pg8::Unit& u, int wr, int wc, int fr, int fq) const {
        const int row0 = u.pm * 256 + wr * 64 + fr, col0 = u.pn * 256 + wc * 32 + 8 * fq;
#pragma unroll
        for (int ai = 0; ai < 2; ++ai) {
            v4u gv[4][2], av[4][2];
#pragma unroll
            for (int m = 0; m < 4; ++m)
#pragma unroll
                for (int bj = 0; bj < 2; ++bj) {
                    const size_t off = (size_t)(row0 + ai * 128 + m * 16) * D + col0 + bj * 128;
                    gv[m][bj] = *(const v4u*)(gate + off); av[m][bj] = add ? *(const v4u*)(add + off) : (v4u){0u, 0u, 0u, 0u};
                }
#pragma unroll
            for (int m = 0; m < 4; ++m)
#pragma unroll
                for (int bj = 0; bj < 2; ++bj) {
                    const size_t off = (size_t)(row0 + ai * 128 + m * 16) * D + col0 + bj * 128;
                    const v4u g = gv[m][bj], a = av[m][bj];
                    const f32x4 c0 = acc[ai][bj][m][0], c1 = acc[ai][bj][m][1];
                    float gf[8] = {bflo(g.x), bfhi(g.x), bflo(g.y), bfhi(g.y), bflo(g.z), bfhi(g.z), bflo(g.w), bfhi(g.w)};
#pragma unroll
                    for (int e = 0; e < 8; ++e) gf[e] = sigmoidf_(gf[e]);
                    v4u w;
                    w.x = cvt_pk_bf16(bflo(a.x) + gf[0] * c0[0], bfhi(a.x) + gf[1] * c0[1]);
                    w.y = cvt_pk_bf16(bflo(a.y) + gf[2] * c0[2], bfhi(a.y) + gf[3] * c0[3]);
                    w.z = cvt_pk_bf16(bflo(a.z) + gf[4] * c1[0], bfhi(a.z) + gf[5] * c1[1]);
                    w.w = cvt_pk_bf16(bflo(a.w) + gf[6] * c1[2], bfhi(a.w) + gf[7] * c1[3]);
                    *(v4u*)(out + off) = w;
                }
            asm volatile("" ::: "memory");
        }
    }
};
struct EpiInProj {
    static constexpr bool PERM = true, AFTER_DRAIN = false, ACC_INIT = false;
    const float* rowss; const float* bias; unsigned char* ws; float* vsum; float* vsumsq; const float* tcos; const float* tsin; int tile0; bf16* qout;
    __device__ __forceinline__ void operator()(const f32x4 (&acc)[2][2][4][2], const pg8::Unit& u, int wr, int wc, int fr, int fq) const {
        const int pn = u.pn + tile0, seg = pn >> 2, sub = pn & 3;
        const int oseg = seg == 0 ? 0 : seg == 1 ? 1 : seg == 2 ? 6 : seg == 3 ? 2 : seg == 4 ? 3 : seg == 5 ? 4 : seg == 6 ? 5 : 7;
        const size_t soff = seg == 0 ? WS_S0 : seg == 1 ? WS_S1 : seg == 2 ? WS_S2 : seg == 3 ? WS_S0 : seg == 4 ? WS_S1 : seg == 5 ? WS_S3 : seg == 6 ? WS_S4 : WS_S5;
        bf16* O = seg == 3 ? qout : (bf16*)(ws + soff);
        const int row0 = u.pm * 256 + wr * 64 + fr, lc = wc * 32 + 8 * fq, col0 = sub * 256 + lc;
        const float* bp = bias + oseg * 1024 + col0;
        f32x4 bv[2][2];
#pragma unroll
        for (int bj = 0; bj < 2; ++bj)
#pragma unroll
            for (int n = 0; n < 2; ++n) bv[bj][n] = *(const f32x4*)(bp + bj * 128 + 4 * n);
        float rsv[2][4];
#pragma unroll
        for (int ai = 0; ai < 2; ++ai)
#pragma unroll
            for (int m = 0; m < 4; ++m) rsv[ai][m] = rowss[row0 + ai * 128 + m * 16];
        const bool rot = (seg == 3 || seg == 4);
#pragma unroll
        for (int ai = 0; ai < 2; ++ai) {
            f32x4 tc[4][2], tsv[4][2];
#pragma unroll
            for (int mh = 0; mh < 2; ++mh) {
            if (rot) {
#pragma unroll
                for (int m = 2 * mh; m < 2 * mh + 2; ++m)
#pragma unroll
                    for (int n = 0; n < 2; ++n) { const int pos = (row0 + ai * 128 + m * 16) & (SEQ - 1); tc[m][n] = *(const f32x4*)(tcos + pos * 128 + lc + 4 * n); tsv[m][n] = *(const f32x4*)(tsin + pos * 128 + lc + 4 * n); }
            }
#pragma unroll
            for (int m = 2 * mh; m < 2 * mh + 2; ++m) {
                const int row = row0 + ai * 128 + m * 16;
                const float rs = __builtin_amdgcn_rsqf(rsv[ai][m] * (1.f / 1024.f) + EPS);
                f32x4 v[2][2];
#pragma unroll
                for (int bj = 0; bj < 2; ++bj)
#pragma unroll
                    for (int n = 0; n < 2; ++n) v[bj][n] = acc[ai][bj][m][n] * rs + bv[bj][n];
                if (rot) {
                    const float ks = seg == 4 ? 0.0625f : 1.f;
#pragma unroll
                    for (int n = 0; n < 2; ++n) {
                        const f32x4 c = tc[m][n], s = tsv[m][n];
                        const f32x4 a = v[0][n], b = v[1][n];
                        v[0][n] = (a * c - b * s) * ks; v[1][n] = (b * c + a * s) * ks;
                    }
                } else if (seg == 1) {
#pragma unroll
                    for (int bj = 0; bj < 2; ++bj)
#pragma unroll
                        for (int n = 0; n < 2; ++n) { const f32x2 a = pg8::gelu_pk((f32x2){v[bj][n][0], v[bj][n][1]}), b = pg8::gelu_pk((f32x2){v[bj][n][2], v[bj][n][3]}); v[bj][n] = (f32x4){a.x, a.y, b.x, b.y}; }
                    if (seg == 1) {
                        float s1 = 0.f, s2 = 0.f;
#pragma unroll
                        for (int bj = 0; bj < 2; ++bj)
#pragma unroll
                            for (int n = 0; n < 2; ++n)
#pragma unroll
                                for (int j = 0; j < 4; ++j) { s1 += v[bj][n][j]; s2 += v[bj][n][j] * v[bj][n][j]; }
                        s1 += __shfl_xor(s1, 16); s1 += __shfl_xor(s1, 32); s2 += __shfl_xor(s2, 16); s2 += __shfl_xor(s2, 32);
                        if (fq == 0) { atomicAdd(vsum + row, s1); atomicAdd(vsumsq + row, s2); }
                    }
                }
#pragma unroll
                for (int bj = 0; bj < 2; ++bj) {
                    v4u w; w.x = cvt_pk_bf16(v[bj][0][0], v[bj][0][1]); w.y = cvt_pk_bf16(v[bj][0][2], v[bj][0][3]); w.z = cvt_pk_bf16(v[bj][1][0], v[bj][1][1]); w.w = cvt_pk_bf16(v[bj][1][2], v[bj][1][3]);
                    *(v4u*)(O + (size_t)row * D + col0 + bj * 128) = w;
                }
            }
            asm volatile("" ::: "memory");
            }
        }
    }
};

__device__ __forceinline__ float wave_sum(float v) {
#pragma unroll
    for (int o = 1; o < 64; o <<= 1) v += __shfl_xor(v, o);
    return v;
}
struct Ctx { const float* in[21]; float* out; unsigned char* ws; };
__device__ __forceinline__ int dest_row(int mode, int n0) {
    if (mode == 1) return 256 * (n0 >> 7) + (n0 & 127);
    if (mode == 2) return 256 * (n0 >> 7) + 128 + (n0 & 127);
    if (mode == 3) { const int os = n0 >> 10; const int ns = os == 0 ? 0 : os == 1 ? 1 : os == 2 ? 3 : os == 3 ? 4 : os == 4 ? 5 : os == 5 ? 6 : os == 6 ? 2 : 7; return ns * 1024 + (n0 & 1023); }
    return n0;
}
struct TJob { const float* W; bf16* WT; const float* ks; int K, N, mode, it; };
__device__ __forceinline__ TJob tjob(const Ctx& C, int list, int g) {
    unsigned char* ws = C.ws; unsigned char* ob = (unsigned char*)C.out; TJob j;
    if (list == 0) {
        if (g < 176)       { j.W = C.in[2];  j.WT = (bf16*)(ws + WS_WGU); j.ks = nullptr; j.K = D;  j.N = FF;    j.mode = 1; j.it = g; }
        else if (g < 352)  { j.W = C.in[3];  j.WT = (bf16*)(ws + WS_WGU); j.ks = nullptr; j.K = D;  j.N = FF;    j.mode = 2; j.it = g - 176; }
        else if (g < 528)  { j.W = C.in[4];  j.WT = (bf16*)(ws + WS_WD);  j.ks = nullptr; j.K = FF; j.N = D;     j.mode = 0; j.it = g - 352; }
        else if (g < 1040) { j.W = C.in[6];  j.WT = (bf16*)(ws + WS_WIN); j.ks = C.in[5]; j.K = D;  j.N = 8 * D; j.mode = 3; j.it = g - 528; }
        else if (g < 1104) { j.W = C.in[13]; j.WT = (bf16*)(ws + WS_WA);  j.ks = nullptr; j.K = D;  j.N = D;     j.mode = 0; j.it = g - 1040; }
        else if (g < 1168) { j.W = C.in[14]; j.WT = (bf16*)(ws + WS_WB);  j.ks = nullptr; j.K = D;  j.N = D;     j.mode = 0; j.it = g - 1104; }
        else               { j.W = C.in[15]; j.WT = (bf16*)(ws + WS_WO);  j.ks = nullptr; j.K = D;  j.N = D;     j.mode = 0; j.it = g - 1168; }
    } else {
        if (g < 176)       { j.W = C.in[17]; j.WT = (bf16*)(ob + 32 * MiB); j.ks = C.in[16]; j.K = D;  j.N = FF; j.mode = 1; j.it = g; }
        else if (g < 352)  { j.W = C.in[18]; j.WT = (bf16*)(ob + 32 * MiB); j.ks = C.in[16]; j.K = D;  j.N = FF; j.mode = 2; j.it = g - 176; }
        else               { j.W = C.in[19]; j.WT = (bf16*)(ws + WS_WD2);  j.ks = nullptr;  j.K = FF; j.N = D;  j.mode = 0; j.it = g - 352; }
    }
    return j;
}
__device__ __forceinline__ void transpose_list(const Ctx& C, int list, int total, LAS unsigned char* img, int cb, int ncb, int tid, int wave, int lane) {
    const int g = lane >> 4, q = (lane & 15) >> 2, p = lane & 3;
    int it = cb; if (it >= total) return;
    TJob J = tjob(C, list, it);
    f32x4 v[8];
    { const int nblk = J.N / 256, k0 = 64 * (J.it / nblk), n0 = 256 * (J.it % nblk);
#pragma unroll
      for (int i = 0; i < 8; ++i) v[i] = __builtin_nontemporal_load((const f32x4*)(J.W + (size_t)(k0 + wave + 8 * i) * J.N + n0 + 4 * lane)); }
    for (;;) {
        const int nblk = J.N / 256, k0 = 64 * (J.it / nblk), n0 = 256 * (J.it % nblk);
        __syncthreads();
#pragma unroll
        for (int i = 0; i < 8; ++i) { const float s = J.ks ? J.ks[k0 + wave + 8 * i] : 1.f; v2u w; w.x = cvt_pk_bf16(v[i][0] * s, v[i][1] * s); w.y = cvt_pk_bf16(v[i][2] * s, v[i][3] * s);
            *(LAS v2u*)(img + (wave + 8 * i) * 544 + 8 * lane) = w; }
        const int nit = it + ncb; TJob Jn = J;
        if (nit < total) { Jn = tjob(C, list, nit); const int nb2 = Jn.N / 256, k2 = 64 * (Jn.it / nb2), n2 = 256 * (Jn.it % nb2);
#pragma unroll
            for (int i = 0; i < 8; ++i) v[i] = __builtin_nontemporal_load((const f32x4*)(Jn.W + (size_t)(k2 + wave + 8 * i) * Jn.N + n2 + 4 * lane)); }
        __syncthreads();
#pragma unroll
        for (int j = 0; j < 4; ++j) {
            const int blk = wave * 4 + j, kh = blk & 1, nb = blk >> 1;
            const LAS unsigned char* a = img + (32 * kh + 8 * g + q) * 544 + (16 * nb + 4 * p) * 2;
            const s16x4 lo = __builtin_amdgcn_ds_read_tr16_b64_v4i16((LAS s16x4*)a);
            const s16x4 hi = __builtin_amdgcn_ds_read_tr16_b64_v4i16((LAS s16x4*)(a + 4 * 544));
            const bf16x8 o = __builtin_shufflevector(lo, hi, 0, 1, 2, 3, 4, 5, 6, 7);
            *(bf16x8*)(J.WT + (size_t)(dest_row(J.mode, n0 + 16 * nb) + (lane & 15)) * J.K + k0 + 32 * kh + 8 * g) = o;
        }
        if (nit >= total) break;
        it = nit; J = Jn;
    }
}
__device__ __forceinline__ bf16x8 tr_frag(const LAS unsigned char* img, int stride, int tok0, int ch0, int lane) {
    const int g = lane >> 4, q = (lane & 15) >> 2, p = lane & 3;
    const LAS unsigned char* a = img + (tok0 + 4 * g + q) * stride + (ch0 + 4 * p) * 2;
    const s16x4 lo = __builtin_amdgcn_ds_read_tr16_b64_v4i16((LAS s16x4*)a);
    const s16x4 hi = __builtin_amdgcn_ds_read_tr16_b64_v4i16((LAS s16x4*)(a + 16 * stride));
    return __builtin_shufflevector(lo, hi, 0, 1, 2, 3, 4, 5, 6, 7);
}
#define MFMA16(a, b, c) __builtin_amdgcn_mfma_f32_16x16x32_bf16((a), (b), (c), 0, 0, 0)
constexpr int IMG = 544;
constexpr int IMGH = 288;


__device__ __forceinline__ void p0_prologue(const Ctx& C, LAS unsigned char* lds, int tid, int wave, int lane) {
    asm volatile("" : "+v"(tid)); wave = __builtin_amdgcn_readfirstlane(tid >> 6); lane = tid & 63;
    const int G = gridDim.x, gw = blockIdx.x * 8 + wave, ngw = G * 8, gt = blockIdx.x * 512 + tid, ngt = G * 512;
    unsigned char* ws = C.ws;
    float* st = (float*)(ws + WS_STAT);
    for (int i = gt; i < 5 * M + 4096; i += ngt) st[i] = 0.f;
    float* tc = (float*)(ws + WS_TAB); float* tsn = tc + SEQ * 128;
    {
        const int fi = gt & 127;
        const float th = powf(10000.f, -(float)(2 * fi) / 256.f);
        for (int i = gt; i < SEQ * 128; i += ngt) { const int pos = i >> 7; const float ang = (float)pos * th, k = rintf(ang * 0.15915494309f);
            float r = fmaf(-k, 6.2831854820251465f, ang); r = fmaf(-k, -1.7484555e-7f, r); const float xr = r * 0.15915494309f;
            tc[i] = __builtin_amdgcn_cosf(xr); tsn[i] = __builtin_amdgcn_sinf(xr); }
    }
    transpose_list(C, 0, 1232, lds, (int)blockIdx.x, G, tid, wave, lane);
    const float* x = C.in[0]; const float* gn = C.in[1]; bf16* xb = (bf16*)(ws + WS_XB); bf16* x16 = (bf16*)(ws + WS_S3);
    for (int m = gw; m < M; m += 2 * ngw) {
        const int m2 = (m + ngw < M) ? m + ngw : m;
        const f32x4* xr = (const f32x4*)(x + (size_t)m * D) + lane; const f32x4* xr2 = (const f32x4*)(x + (size_t)m2 * D) + lane; f32x4 v[4], v2[4]; float s = 0.f, s2 = 0.f;
#pragma unroll
        for (int j = 0; j < 4; ++j) { v[j] = __builtin_nontemporal_load(xr + 64 * j); v2[j] = __builtin_nontemporal_load(xr2 + 64 * j); }
#pragma unroll
        for (int j = 0; j < 4; ++j) { s += (v[j][0] * v[j][0] + v[j][1] * v[j][1]) + (v[j][2] * v[j][2] + v[j][3] * v[j][3]); s2 += (v2[j][0] * v2[j][0] + v2[j][1] * v2[j][1]) + (v2[j][2] * v2[j][2] + v2[j][3] * v2[j][3]); }
        const float rs = __builtin_amdgcn_rsqf(wave_sum(s) * (1.f / D) + EPS), rs2 = __builtin_amdgcn_rsqf(wave_sum(s2) * (1.f / D) + EPS);
#pragma unroll
        for (int j = 0; j < 4; ++j) { const f32x4 g = ((const f32x4*)gn)[lane + 64 * j]; const f32x4 o = v[j] * rs * g, o2 = v2[j] * rs2 * g;
            v2u w; w.x = cvt_pk_bf16(o[0], o[1]); w.y = cvt_pk_bf16(o[2], o[3]); ((v2u*)(xb + (size_t)m * D))[lane + 64 * j] = w;
            v2u w2; w2.x = cvt_pk_bf16(o2[0], o2[1]); w2.y = cvt_pk_bf16(o2[2], o2[3]); ((v2u*)(xb + (size_t)m2 * D))[lane + 64 * j] = w2;
            v2u r; r.x = cvt_pk_bf16(v[j][0], v[j][1]); r.y = cvt_pk_bf16(v[j][2], v[j][3]); ((v2u*)(x16 + (size_t)m * D))[lane + 64 * j] = r;
            v2u r2; r2.x = cvt_pk_bf16(v2[j][0], v2[j][1]); r2.y = cvt_pk_bf16(v2[j][2], v2[j][3]); ((v2u*)(x16 + (size_t)m2 * D))[lane + 64 * j] = r2; }
    }
}

constexpr size_t OUT_WGU2 = 32 * MiB;
__device__ __forceinline__ void convert_rest(const Ctx& C, LAS unsigned char* lds, int cb, int ncb, int tid, int wave, int lane) {
    asm volatile("" : "+v"(tid)); wave = __builtin_amdgcn_readfirstlane(tid >> 6); lane = tid & 63;
    transpose_list(C, 1, 528, lds, cb, ncb, tid, wave, lane);
}

__device__ __forceinline__ void sgu_phase(const Ctx& C, LAS unsigned char* lds, int tid, int wave, int lane) {
    asm volatile("" : "+v"(tid)); wave = __builtin_amdgcn_readfirstlane(tid >> 6); lane = tid & 63;
    const int fr = lane & 15, fq = lane >> 4;
    unsigned char* ws = C.ws;
    bf16* U = (bf16*)(ws + WS_S0); const bf16* V = (const bf16*)(ws + WS_S1);
    const float* vsum = (const float*)(ws + WS_STAT) + 2 * M; const float* vsumsq = vsum + M;
    const float* ng = C.in[8]; const float* nb = C.in[9]; const float* Wsp = C.in[10]; const float* bsp = C.in[11];
    for (int unit = blockIdx.x; unit < 512; unit += gridDim.x) {
        const int g = unit & 3, m0 = (unit >> 2) * 128, d0 = g * 256;
        __syncthreads();
#pragma unroll
        for (int i = 0; i < 8; ++i) {
            const int idx = tid + 512 * i, tok = idx >> 5, c8 = idx & 31;
            const v4u raw = *(const v4u*)(V + (size_t)(m0 + tok) * D + d0 + c8 * 8);
            const float mu = vsum[m0 + tok] * (1.f / 1024.f), var = vsumsq[m0 + tok] * (1.f / 1024.f) - mu * mu, rs = __builtin_amdgcn_rsqf(var + EPS);
            const f32x4 g0 = *(const f32x4*)(ng + d0 + c8 * 8), g1 = *(const f32x4*)(ng + d0 + c8 * 8 + 4), b0 = *(const f32x4*)(nb + d0 + c8 * 8), b1 = *(const f32x4*)(nb + d0 + c8 * 8 + 4);
            v4u w;
            w.x = cvt_pk_bf16((bflo(raw.x) - mu) * rs * g0[0] + b0[0], (bfhi(raw.x) - mu) * rs * g0[1] + b0[1]);
            w.y = cvt_pk_bf16((bflo(raw.y) - mu) * rs * g0[2] + b0[2], (bfhi(raw.y) - mu) * rs * g0[3] + b0[3]);
            w.z = cvt_pk_bf16((bflo(raw.z) - mu) * rs * g1[0] + b1[0], (bfhi(raw.z) - mu) * rs * g1[1] + b1[1]);
            w.w = cvt_pk_bf16((bflo(raw.w) - mu) * rs * g1[2] + b1[2], (bfhi(raw.w) - mu) * rs * g1[3] + b1[3]);
            *(LAS v4u*)(lds + tok * IMG + c8 * 16) = w;
        }
        __syncthreads();
        const int c = wave * 16 + fr;
        bf16x8 wf[4];
#pragma unroll
        for (int kk = 0; kk < 4; ++kk) {
            const float* wp = Wsp + ((size_t)g * 128 + c) * 128 + 32 * kk + 4 * fq;
            const f32x4 a = *(const f32x4*)wp, b = *(const f32x4*)(wp + 16);
            v4u w; w.x = cvt_pk_bf16(a[0], a[1]); w.y = cvt_pk_bf16(a[2], a[3]); w.z = cvt_pk_bf16(b[0], b[1]); w.w = cvt_pk_bf16(b[2], b[3]);
            wf[kk] = __builtin_bit_cast(bf16x8, w);
        }
        f32x4 acc[16];
#pragma unroll
        for (int j = 0; j < 16; ++j) acc[j] = (f32x4){0.f, 0.f, 0.f, 0.f};
#pragma unroll
        for (int kk = 0; kk < 4; ++kk)
#pragma unroll
            for (int j = 0; j < 16; ++j) { const bf16x8 a = tr_frag(lds, IMG, 32 * kk, 16 * j, lane); acc[j] = MFMA16(a, wf[kk], acc[j]); }
        const float bsv = bsp[g * 128 + c];
        bf16* up = U + (size_t)(m0 + c) * D + d0 + 4 * fq;
#pragma unroll
        for (int j = 0; j < 16; ++j) {
            const v2u uu = *(const v2u*)(up + 16 * j);
            const f32x2 ga = pg8::gelu_pk((f32x2){bflo(uu.x), bfhi(uu.x)}), gb2 = pg8::gelu_pk((f32x2){bflo(uu.y), bfhi(uu.y)});
            v2u w; w.x = cvt_pk_bf16(ga.x * (acc[j][0] + bsv), ga.y * (acc[j][1] + bsv)); w.y = cvt_pk_bf16(gb2.x * (acc[j][2] + bsv), gb2.y * (acc[j][3] + bsv));
            *(v2u*)(up + 16 * j) = w;
        }
    }
}

__device__ __forceinline__ float lg2gamma(const float* logit, int dir, int h) { const float x = logit[dir * NH + h]; return -log1pf(expf(-x)) * 1.44269504f; }
constexpr int SC = 512;

constexpr int IMGQ = 160;
__device__ __forceinline__ void r1_phase(const Ctx& C, LAS unsigned char* lds, int tid, int wave, int lane) {
    asm volatile("" : "+v"(tid)); wave = __builtin_amdgcn_readfirstlane(tid >> 6); lane = tid & 63;
    if (wave >= 4) __builtin_amdgcn_s_setprio(1);
    const int fr = lane & 15, fq = lane >> 4, jw = wave & 3, ih = wave >> 2;
    unsigned char* ws = C.ws;
    const bf16* Kp = (const bf16*)(ws + WS_S1); const bf16* Vp = (const bf16*)(ws + WS_S3); bf16* ST = (bf16*)(ws + WS_S0);
    LAS unsigned char* kimg = lds; LAS unsigned char* vimg = lds + 128 * IMG;
    v4u pk[8], pv[2];
#define R1_LOAD(u_, s_) do { const int dvq_ = (u_) & 3, sc_ = ((u_) >> 2) & 7, bh_ = (u_) >> 5; const size_t t0_ = (size_t)(bh_ >> 2) * SEQ + sc_ * SC + (s_) * 128; const int h_ = bh_ & 3; \
        _Pragma("unroll") for (int i_ = 0; i_ < 8; ++i_) { const int idx_ = tid + 512 * i_; pk[i_] = *(const v4u*)(Kp + (t0_ + (idx_ >> 5)) * D + h_ * 256 + (idx_ & 31) * 8); } \
        _Pragma("unroll") for (int i_ = 0; i_ < 2; ++i_) { const int idx_ = tid + 512 * i_; pv[i_] = *(const v4u*)(Vp + (t0_ + (idx_ >> 3)) * D + h_ * 256 + dvq_ * 64 + (idx_ & 7) * 8); } } while (0)
    const int vcu = (gridDim.x % 8 == 0) ? (int)((blockIdx.x % 8) * (gridDim.x / 8) + blockIdx.x / 8) : (int)blockIdx.x;
    if (vcu < 512) R1_LOAD(vcu, 0);
    for (int unit = vcu; unit < 512; unit += gridDim.x) {
        const int dvq = unit & 3, sc = (unit >> 2) & 7, bh = unit >> 5, h = bh & 3;
        const float lgf = lg2gamma(C.in[12], 0, h), lgb = lg2gamma(C.in[12], 1, h);
        f32x4 acc[2][8];
#pragma unroll
        for (int d = 0; d < 2; ++d)
#pragma unroll
            for (int i = 0; i < 8; ++i) acc[d][i] = (f32x4){0.f, 0.f, 0.f, 0.f};
#pragma unroll 1
        for (int sub = 0; sub < 4; ++sub) {
            __syncthreads();
#pragma unroll
            for (int i = 0; i < 8; ++i) { const int idx = tid + 512 * i; *(LAS v4u*)(kimg + (idx >> 5) * IMG + (idx & 31) * 16) = pk[i]; }
#pragma unroll
            for (int i = 0; i < 2; ++i) { const int idx = tid + 512 * i; *(LAS v4u*)(vimg + (idx >> 3) * IMGQ + (idx & 7) * 16) = pv[i]; }
            __syncthreads();
            if (sub < 3) R1_LOAD(unit, sub + 1); else if (unit + (int)gridDim.x < 512) R1_LOAD(unit + (int)gridDim.x, 0);
#pragma unroll
            for (int kk = 0; kk < 4; ++kk) {
                const bf16x8 vr = tr_frag(vimg, IMGQ, 32 * kk, 16 * jw, lane);
                const v4u vw = __builtin_bit_cast(v4u, vr);
                float ve[8] = {bflo(vw.x), bfhi(vw.x), bflo(vw.y), bfhi(vw.y), bflo(vw.z), bfhi(vw.z), bflo(vw.w), bfhi(vw.w)};
                float of[8], ob[8];
#pragma unroll
                for (int e = 0; e < 8; ++e) { const int cc = sub * 128 + 32 * kk + 16 * (e >> 2) + 4 * fq + (e & 3);
                    of[e] = ve[e] * __builtin_amdgcn_exp2f((float)(SC - 1 - cc) * lgf); ob[e] = ve[e] * __builtin_amdgcn_exp2f((float)cc * lgb); }
                v4u wF, wB;
                wF.x = cvt_pk_bf16(of[0], of[1]); wF.y = cvt_pk_bf16(of[2], of[3]); wF.z = cvt_pk_bf16(of[4], of[5]); wF.w = cvt_pk_bf16(of[6], of[7]);
                wB.x = cvt_pk_bf16(ob[0], ob[1]); wB.y = cvt_pk_bf16(ob[2], ob[3]); wB.z = cvt_pk_bf16(ob[4], ob[5]); wB.w = cvt_pk_bf16(ob[6], ob[7]);
                const bf16x8 vF = __builtin_bit_cast(bf16x8, wF), vB = __builtin_bit_cast(bf16x8, wB);
#pragma unroll
                for (int i = 0; i < 8; ++i) { const bf16x8 kf = tr_frag(kimg, IMG, 32 * kk, 128 * ih + 16 * i, lane); acc[0][i] = MFMA16(kf, vF, acc[0][i]); acc[1][i] = MFMA16(kf, vB, acc[1][i]); }
            }
        }
#pragma unroll
        for (int d = 0; d < 2; ++d) {
            bf16* sp = ST + ((size_t)((bh * 2 + d) * 8 + sc) * 256 + dvq * 64 + 16 * jw + fr) * 256 + 128 * ih + 4 * fq;
#pragma unroll
            for (int i = 0; i < 8; ++i) { v2u w; w.x = cvt_pk_bf16(acc[d][i][0], acc[d][i][1]); w.y = cvt_pk_bf16(acc[d][i][2], acc[d][i][3]); *(v2u*)(sp + 16 * i) = w; }
        }
    }
    __builtin_amdgcn_s_setprio(0);
}
__device__ __forceinline__ void r2_phase(const Ctx& C, int tid) {
    asm volatile("" : "+v"(tid));
    bf16* ST = (bf16*)(C.ws + WS_S0);
    const int gt = blockIdx.x * 512 + tid, ngt = gridDim.x * 512;
    for (int idx = gt; idx < 32 * 8192; idx += ngt) {
        const int e8 = idx & 8191, bd = idx >> 13, dir = bd & 1, h = (bd >> 1) & 3;
        const float cd = __builtin_amdgcn_exp2f((float)SC * lg2gamma(C.in[12], dir, h));
        v4u* base = (v4u*)(ST + (size_t)(bd * 8) * 65536 + e8 * 8);
        v4u raw[8];
#pragma unroll
        for (int s = 0; s < 8; ++s) raw[s] = base[(size_t)(dir ? 7 - s : s) * 8192];
        float carry[8];
#pragma unroll
        for (int e = 0; e < 8; ++e) carry[e] = 0.f;
#pragma unroll
        for (int s = 0; s < 8; ++s) {
            v4u w; w.x = cvt_pk_bf16(carry[0], carry[1]); w.y = cvt_pk_bf16(carry[2], carry[3]); w.z = cvt_pk_bf16(carry[4], carry[5]); w.w = cvt_pk_bf16(carry[6], carry[7]);
            base[(size_t)(dir ? 7 - s : s) * 8192] = w;
            const v4u r = raw[s];
            carry[0] = carry[0] * cd + bflo(r.x); carry[1] = carry[1] * cd + bfhi(r.x); carry[2] = carry[2] * cd + bflo(r.y); carry[3] = carry[3] * cd + bfhi(r.y);
            carry[4] = carry[4] * cd + bflo(r.z); carry[5] = carry[5] * cd + bfhi(r.z); carry[6] = carry[6] * cd + bflo(r.w); carry[7] = carry[7] * cd + bfhi(r.w);
        }
    }
}
__device__ __forceinline__ void stage64(LAS unsigned char* img, const bf16* src, size_t pitch, int tid) {
#pragma unroll
    for (int i = 0; i < 4; ++i) { const int idx = tid + 512 * i, r = idx >> 5, c8 = idx & 31; *(LAS v4u*)(img + r * IMG + c8 * 16) = *(const v4u*)(src + (size_t)r * pitch + c8 * 8); }
}
struct R3Src { const bf16* p0; const bf16* p1; int pitch; };
__device__ __forceinline__ R3Src r3_src(const bf16* ST, const bf16* Kp, const bf16* Vp, int unit, int s) {
    const int qb = unit & 31, bh = unit >> 5, b = bh >> 2, h = bh & 3, sc = qb >> 2;
    R3Src r;
    if (s < 4) { r.p0 = ST + ((size_t)((bh * 2 + 0) * 8 + sc) * 256 + 64 * s) * 256; r.p1 = ST + ((size_t)((bh * 2 + 1) * 8 + sc) * 256 + 64 * s) * 256; r.pitch = 256; }
    else { const size_t k0 = (size_t)b * SEQ + sc * SC + (s - 4) * 64; r.p0 = Kp + k0 * D + h * 256; r.p1 = Vp + k0 * D + h * 256; r.pitch = D; }
    return r;
}
constexpr int R3_TILE = 64 * IMG, R3_SET = 2 * R3_TILE;
#define R3_DMA(sp, setp) do { const int pb_ = (sp).pitch * 2; _Pragma("unroll") for (int i_ = 0; i_ < 5; ++i_) { if (i_ < 4 || wave < 2) { const int n_ = wave + 8 * i_; \
        __builtin_amdgcn_global_load_lds((const unsigned*)((const char*)(sp).p0 + (size_t)(drow[i_] * pb_ + dcb[i_])), (LAS unsigned*)((setp) + 1024 * n_), 16, 0, 0); \
        __builtin_amdgcn_global_load_lds((const unsigned*)((const char*)(sp).p1 + (size_t)(drow[i_] * pb_ + dcb[i_])), (LAS unsigned*)((setp) + R3_TILE + 1024 * n_), 16, 0, 0); } } } while (0)
#define R3_WAIT() asm volatile("s_waitcnt vmcnt(0)" ::: "memory")
__device__ __forceinline__ void r3_phase(const Ctx& C, LAS unsigned char* lds, int tid, int wave, int lane) {
    asm volatile("" : "+v"(tid)); wave = __builtin_amdgcn_readfirstlane(tid >> 6); lane = tid & 63;
    if (wave >= 4) __builtin_amdgcn_s_setprio(1);
    const int fr = lane & 15, fq = lane >> 4;
    int drow[5], dcb[5];
#pragma unroll
    for (int i = 0; i < 5; ++i) { const int o = 1024 * (wave + 8 * i) + 16 * lane, cb = o % IMG; drow[i] = o / IMG; dcb[i] = cb < 512 ? cb : 0; }
    unsigned char* ws = C.ws;
    bf16* Qp = (bf16*)C.out; const bf16* Kp = (const bf16*)(ws + WS_S1); const bf16* Vp = (const bf16*)(ws + WS_S3); const bf16* Gp = (const bf16*)(ws + WS_S4); const bf16* ST = (const bf16*)(ws + WS_S0);
    int unit = (gridDim.x % 8 == 0) ? (int)((blockIdx.x % 8) * (gridDim.x / 8) + blockIdx.x / 8) : (int)blockIdx.x;
    if (unit < 512) { const R3Src sp = r3_src(ST, Kp, Vp, unit, 0); __syncthreads(); R3_DMA(sp, lds); R3_WAIT(); __syncthreads(); }
    for (; unit < 512; unit += gridDim.x) {
        const int nunit = unit + gridDim.x;
        const int qb = unit & 31, bh = unit >> 5, b = bh >> 2, h = bh & 3;
        const float lgf = lg2gamma(C.in[12], 0, h), lgb = lg2gamma(C.in[12], 1, h);
        const size_t row = (size_t)b * SEQ + qb * 128 + 16 * wave + fr;
        const int ccq = (qb & 3) * 128 + 16 * wave + fr;
        bf16x8 qf[8];
#pragma unroll
        for (int kk = 0; kk < 8; ++kk) qf[kk] = *(const bf16x8*)(Qp + row * D + h * 256 + 32 * kk + 8 * fq);
        f32x4 acc[16];
        const float ff = __builtin_amdgcn_exp2f((float)(ccq + 1) * lgf), fb = __builtin_amdgcn_exp2f((float)(SC - ccq) * lgb);
        float colF[16], colB[16];
#pragma unroll
        for (int e = 0; e < 16; ++e) { const int j = 16 * (e >> 2) + 4 * fq + (e & 3); colF[e] = __builtin_amdgcn_exp2f(-(float)j * lgf); colB[e] = __builtin_amdgcn_exp2f((float)j * lgb); }
        const int kbd = ((qb & 3) * 128 + 16 * wave) >> 6;
#pragma unroll
        for (int s = 0; s < 4; ++s) {
            { const R3Src sp = r3_src(ST, Kp, Vp, unit, s + 1); R3_DMA(sp, lds + ((s + 1) & 1) * R3_SET); }
            const LAS unsigned char* bK = lds + (s & 1) * R3_SET; const LAS unsigned char* bV = bK + R3_TILE;
            f32x4 tF[4], tB[4];
#pragma unroll
            for (int jj = 0; jj < 4; ++jj) { tF[jj] = (f32x4){0.f, 0.f, 0.f, 0.f}; tB[jj] = (f32x4){0.f, 0.f, 0.f, 0.f}; }
#pragma unroll
            for (int jj = 0; jj < 4; ++jj)
#pragma unroll
                for (int kk = 0; kk < 8; ++kk) {
                    const bf16x8 sf = *(const LAS bf16x8*)(bK + (16 * jj + fr) * IMG + (32 * kk + 8 * fq) * 2);
                    const bf16x8 sb = *(const LAS bf16x8*)(bV + (16 * jj + fr) * IMG + (32 * kk + 8 * fq) * 2);
                    tF[jj] = MFMA16(sf, qf[kk], tF[jj]); tB[jj] = MFMA16(sb, qf[kk], tB[jj]);
                }
#pragma unroll
            for (int jj = 0; jj < 4; ++jj) acc[4 * s + jj] = tF[jj] * ff + tB[jj] * fb;
            R3_WAIT();
            __syncthreads();
        }
#pragma unroll 1
        for (int kb = 0; kb < 8; ++kb) {
            const bool has_next = (kb < 7) || (nunit < 512);
            if (has_next) { const R3Src sp = (kb < 7) ? r3_src(ST, Kp, Vp, unit, kb + 5) : r3_src(ST, Kp, Vp, nunit, 0); R3_DMA(sp, lds + ((kb + 1) & 1) * R3_SET); }
            const LAS unsigned char* bK = lds + (kb & 1) * R3_SET; const LAS unsigned char* bV = bK + R3_TILE;
            f32x4 P[4];
#pragma unroll
            for (int mb = 0; mb < 4; ++mb) {
                P[mb] = (f32x4){0.f, 0.f, 0.f, 0.f};
#pragma unroll
                for (int kk = 0; kk < 8; ++kk) { const bf16x8 kf = *(const LAS bf16x8*)(bK + (16 * mb + fr) * IMG + (32 * kk + 8 * fq) * 2); P[mb] = MFMA16(kf, qf[kk], P[mb]); }
            }
            if (kb < kbd) {
                const float rf = __builtin_amdgcn_exp2f((float)(ccq - kb * 64) * lgf);
#pragma unroll
                for (int mb = 0; mb < 4; ++mb)
#pragma unroll
                    for (int r = 0; r < 4; ++r) P[mb][r] *= rf * colF[4 * mb + r];
            } else if (kb > kbd) {
                const float rb = __builtin_amdgcn_exp2f((float)(kb * 64 - ccq) * lgb);
#pragma unroll
                for (int mb = 0; mb < 4; ++mb)
#pragma unroll
                    for (int r = 0; r < 4; ++r) P[mb][r] *= rb * colB[4 * mb + r];
            } else {
#pragma unroll
                for (int mb = 0; mb < 4; ++mb)
#pragma unroll
                    for (int r = 0; r < 4; ++r) { const int dd = ccq - (kb * 64 + 16 * mb + 4 * fq + r); const float e = dd >= 0 ? (float)dd * lgf : (float)(-dd) * lgb; P[mb][r] *= __builtin_amdgcn_exp2f(e); }
            }
#pragma unroll
            for (int t2 = 0; t2 < 2; ++t2) {
                v4u w; w.x = cvt_pk_bf16(P[2 * t2][0], P[2 * t2][1]); w.y = cvt_pk_bf16(P[2 * t2][2], P[2 * t2][3]); w.z = cvt_pk_bf16(P[2 * t2 + 1][0], P[2 * t2 + 1][1]); w.w = cvt_pk_bf16(P[2 * t2 + 1][2], P[2 * t2 + 1][3]);
                const bf16x8 pf = __builtin_bit_cast(bf16x8, w);
#pragma unroll
                for (int j = 0; j < 16; ++j) { const bf16x8 vf = tr_frag(bV, IMG, 32 * t2, 16 * j, lane); acc[j] = MFMA16(vf, pf, acc[j]); }
            }
            R3_WAIT();
            __syncthreads();
        }
        float ss = 0.f;
#pragma unroll
        for (int j = 0; j < 16; ++j) ss += (acc[j][0] * acc[j][0] + acc[j][1] * acc[j][1]) + (acc[j][2] * acc[j][2] + acc[j][3] * acc[j][3]);
        ss += __shfl_xor(ss, 16); ss += __shfl_xor(ss, 32);
        const float rs = __builtin_amdgcn_rsqf(ss * (1.f / 256.f) + EPS);
        const size_t ob = row * D + h * 256 + 4 * fq;
#pragma unroll
        for (int j = 0; j < 16; ++j) {
            const v2u gg = *(const v2u*)(Gp + ob + 16 * j);
            v2u w; w.x = cvt_pk_bf16(acc[j][0] * rs * siluf_(bflo(gg.x)), acc[j][1] * rs * siluf_(bfhi(gg.x))); w.y = cvt_pk_bf16(acc[j][2] * rs * siluf_(bflo(gg.y)), acc[j][3] * rs * siluf_(bfhi(gg.y)));
            *(v2u*)(Qp + ob + 16 * j) = w;
        }
    }
    __builtin_amdgcn_s_setprio(0);
}

#define XB_TMO      128
#define XB_XCNT(j)  (256  + 64 * (j))
#define XB_XSUB(j)  (1280 + 64 * (j))
#define XB_XGEN(j)  (2304 + 64 * (j))
#define XB_TOP      3328
#define XB_TOPGEN   3392
#define XCD_BAR_WORDS 3456
#define XB_SPIN_CAP (1u << 18)

__device__ __forceinline__ unsigned xb_ld(unsigned* p)              { return __hip_atomic_load(p, __ATOMIC_RELAXED, __HIP_MEMORY_SCOPE_AGENT); }
__device__ __forceinline__ unsigned xb_add(unsigned* p, unsigned v) { return __hip_atomic_fetch_add(p, v, __ATOMIC_RELAXED, __HIP_MEMORY_SCOPE_AGENT); }
__device__ __forceinline__ unsigned xb_xcc_id() { return (unsigned)__builtin_amdgcn_s_getreg((3 << 11) | 20) & 0xFu; }
#define XB_SPIN(cond, bar) do { unsigned _sp = 0; while (cond) { __builtin_amdgcn_s_sleep(1); \
    if ((++_sp & 255u) == 0u) { if (xb_ld(&(bar)[XB_TMO])) break; if (_sp > XB_SPIN_CAP) { atomicAdd(&(bar)[XB_TMO], 1u); break; } } } } while (0)

struct XcdBarrier {
    unsigned* bar; unsigned x;
    volatile LAS unsigned* st;
};

__device__ __forceinline__ XcdBarrier xcd_barrier_post(unsigned* bar, volatile LAS unsigned* st) {
    XcdBarrier b; b.bar = bar; b.x = xb_xcc_id(); b.st = st;
    if (threadIdx.x == 0) (void)xb_add(&bar[XB_XCNT(b.x)], 1u);
    return b;
}
__device__ __forceinline__ void xcd_barrier_complete(unsigned* bar, unsigned x, unsigned& nloc, unsigned& nx) {
    const unsigned G = gridDim.x * gridDim.y * gridDim.z;
    unsigned sum, cnt, mine, sp = 0u;
    for (;;) {
        sum = 0u; cnt = 0u; mine = 0u;
#pragma unroll
        for (unsigned j = 0; j < 16; ++j) { const unsigned c = xb_ld(&bar[XB_XCNT(j)]); sum += c; cnt += (c > 0u) ? 1u : 0u; mine = (j == x) ? c : mine; }
        if (sum == G) break;
        __builtin_amdgcn_s_sleep(1);
        if ((++sp & 255u) == 0u) { if (xb_ld(&bar[XB_TMO])) break; if (sp > XB_SPIN_CAP) { atomicAdd(&bar[XB_TMO], 1u); break; } }
    }
    nloc = mine > 0u ? mine : 1u; nx = cnt > 0u ? cnt : 1u;
}

__device__ __forceinline__ void xcd_barrier(const XcdBarrier& b) {
    asm volatile("s_waitcnt vmcnt(0)" ::: "memory");
    __syncthreads();
    if (threadIdx.x == 0) {
        unsigned* bar = b.bar;
        __builtin_amdgcn_s_waitcnt(0);
        unsigned nloc = b.st[0], nx = b.st[1];
        if (nloc == 0u) { xcd_barrier_complete(bar, b.x, nloc, nx); b.st[0] = nloc; b.st[1] = nx; }
        const unsigned old = xb_add(&bar[XB_XSUB(b.x)], 1u);
        const unsigned gen = old / nloc;
        if (old + 1u == (gen + 1u) * nloc) {
            __builtin_amdgcn_fence(__ATOMIC_RELEASE, "agent");
            asm volatile("s_waitcnt vmcnt(0)" ::: "memory");
            const unsigned og = xb_add(&bar[XB_TOP], 1u);
            const unsigned tg = og / nx;
            if (og + 1u == (tg + 1u) * nx) xb_add(&bar[XB_TOPGEN], 1u);
            else XB_SPIN(xb_ld(&bar[XB_TOPGEN]) == tg, bar);
            __builtin_amdgcn_fence(__ATOMIC_ACQUIRE, "agent");
            xb_add(&bar[XB_XGEN(b.x)], 1u);
            asm volatile("s_waitcnt vmcnt(0)" ::: "memory");
        } else {
            XB_SPIN(xb_ld(&bar[XB_XGEN(b.x)]) == gen, bar);
            __builtin_amdgcn_fence(__ATOMIC_ACQUIRE, "agent");
            asm volatile("s_waitcnt vmcnt(0)" ::: "memory");
        }
    }
    __syncthreads();
}

#define GEMMX(ABLKv, EpiT, Eobj, Aptr, Btptr, Nn, Kk) do { pg8::Gemm g_{(const pg8::bf16_t*)(Aptr), (const pg8::bf16_t*)(Btptr), M, (Nn), (Kk)}; pg8::StaticOrder S_; S_.init(M, (Nn), (int)gridDim.x, (int)blockIdx.x); \
    pg8::gemm_phase<EpiT, pg8::StaticOrder, true, true, ABLKv>((PG8_LAS unsigned char*)lds, g_, S_, Eobj); } while (0)
#define GEMM(EpiT, Eobj, Aptr, Btptr, Nn, Kk) GEMMX(false, EpiT, Eobj, Aptr, Btptr, Nn, Kk)

__global__ void __launch_bounds__(512, 2) fwd_megakernel(Ctx C) {
    extern __shared__ __attribute__((aligned(16))) unsigned char lds_raw[];
    LAS unsigned char* lds = (LAS unsigned char*)lds_raw;
    cg::grid_group grid = cg::this_grid();
    const int tid = threadIdx.x, wave = __builtin_amdgcn_readfirstlane(tid >> 6), lane = tid & 63;
    unsigned char* ws = C.ws;
    float* stat = (float*)(ws + WS_STAT); float* rowss1 = stat; float* rowss2 = stat + M; float* vsum = stat + 2 * M; float* vsumsq = stat + 3 * M;
    const float* tcos = (const float*)(ws + WS_TAB); const float* tsin = tcos + SEQ * 128;
    bf16* XB = (bf16*)(ws + WS_XB); bf16* ACT = (bf16*)(ws + WS_ACT);

    volatile LAS unsigned* bst = (volatile LAS unsigned*)(lds + LDS_BYTES - 16);
    if (tid == 0) { bst[0] = 0u; bst[1] = 0u; }
    __syncthreads();
    (void)xcd_barrier_post((unsigned*)(ws + WS_BAR), bst);
    if (C.ws == nullptr) grid.sync();
#define GBAR() do { XcdBarrier xb_; xb_.bar = (unsigned*)(C.ws + WS_BAR); xb_.x = xb_xcc_id(); xb_.st = (volatile LAS unsigned*)(lds + LDS_BYTES - 16); xcd_barrier(xb_); } while (0)
    p0_prologue(C, lds, tid, wave, lane);
    GBAR();
    { EpiSwiGLU E{ACT, nullptr}; GEMM(EpiSwiGLU, E, XB, ws + WS_WGU, 2 * FF, D); }
    {
        const int G = (int)gridDim.x, tail = (64 * 22) % G; int cb = -1, ncb = 1;
        if (tail == 0) { cb = (int)blockIdx.x; ncb = G; } else if ((int)blockIdx.x >= tail) { cb = (int)blockIdx.x - tail; ncb = G - tail; }
        if (cb >= 0) convert_rest(C, lds, cb, ncb, tid, wave, lane);
    }
    GBAR();
    { EpiResid E{(const bf16*)(ws + WS_S3), nullptr, XB, rowss1, 0.5f}; GEMMX(true, EpiResid, E, ACT, ws + WS_WD, D, FF); }
    GBAR();
    { EpiInProj E{rowss1, C.in[7], ws, vsum, vsumsq, tcos, tsin, 0, (bf16*)C.out}; GEMM(EpiInProj, E, XB, ws + WS_WIN, 3 * D, D); }
    GBAR();
    sgu_phase(C, lds, tid, wave, lane);
    GBAR();
    { EpiBranch E{(const bf16*)(ws + WS_S2), nullptr, (bf16*)(ws + WS_S2)}; GEMM(EpiBranch, E, ws + WS_S0, ws + WS_WA, D, D); }
    { EpiInProj E{rowss1, C.in[7], ws, vsum, vsumsq, tcos, tsin, 12, (bf16*)C.out}; GEMM(EpiInProj, E, XB, ws + WS_WIN + (size_t)3 * D * D * 2, 5 * D, D); }
    GBAR();
    r1_phase(C, lds, tid, wave, lane);
    GBAR();
    r2_phase(C, tid);
    GBAR();
    r3_phase(C, lds, tid, wave, lane);
    GBAR();
    { EpiBranch E{(const bf16*)(ws + WS_S5), (const bf16*)(ws + WS_S2), (bf16*)(ws + WS_S2)}; GEMM(EpiBranch, E, C.out, ws + WS_WB, D, D); }
    GBAR();
    { EpiResid E{XB, nullptr, XB, rowss2, 1.0f}; GEMM(EpiResid, E, ws + WS_S2, ws + WS_WO, D, D); }
    GBAR();
    { EpiSwiGLU E{ACT, rowss2}; GEMM(EpiSwiGLU, E, XB, (unsigned char*)C.out + OUT_WGU2, 2 * FF, D); }
    GBAR();
    { EpiFinal E{XB, stat + 4 * M, (unsigned*)(ws + WS_CNT), C.in[20], C.out}; GEMMX(true, EpiFinal, E, ACT, ws + WS_WD2, D, FF); }
}

extern "C" void kernel_launch(void* const* d_in, const int* in_sizes, int n_in, void* d_out, int out_size, void* d_ws, size_t ws_size, hipStream_t stream) {
    static int grid = 0;
    if (grid == 0) {
        if (n_in != 21 || out_size != M * D || ws_size < 256 * MiB) { fprintf(stderr, "kernel_launch: unexpected shapes (n_in %d out %d ws %zu)\n", n_in, out_size, ws_size); grid = -1; return; }
        int dev = 0, cus = 0, per_cu = 0;
        hipGetDevice(&dev); hipDeviceGetAttribute(&cus, hipDeviceAttributeMultiprocessorCount, dev);
        if (hipFuncSetAttribute((const void*)fwd_megakernel, hipFuncAttributeMaxDynamicSharedMemorySize, LDS_BYTES) != hipSuccess) { fprintf(stderr, "kernel_launch: hipFuncSetAttribute failed\n"); grid = -1; return; }
        if (hipOccupancyMaxActiveBlocksPerMultiprocessor(&per_cu, (const void*)fwd_megakernel, 512, LDS_BYTES) != hipSuccess || per_cu < 1) { fprintf(stderr, "kernel_launch: occupancy query says %d blocks per CU\n", per_cu); per_cu = 1; }
        (void)hipGetLastError();
        grid = cus * 1;
    }
    if (grid < 0) return;
    if (hipMemsetAsync((char*)d_ws + WS_BAR, 0, XCD_BAR_WORDS * sizeof(unsigned), stream) != hipSuccess) { fprintf(stderr, "kernel_launch: hipMemsetAsync failed\n"); return; }
    Ctx c{};
    for (int i = 0; i < 21; ++i) c.in[i] = (const float*)d_in[i];
    c.out = (float*)d_out; c.ws = (unsigned char*)d_ws;
    void* args[] = {&c};
    hipError_t e = hipLaunchCooperativeKernel((const void*)fwd_megakernel, dim3(grid), dim3(512), args, LDS_BYTES, stream);
    if (e != hipSuccess) fprintf(stderr, "cooperative launch failed: %s (grid %d)\n", hipGetErrorString(e), grid);
}
```
